# Optimizing an MI355X kernel written in HIP

```python
import math
import jax
import jax.numpy as jnp
from jax import lax
import numpy as np

D_MODEL = 1024
BATCH = 4
SEQ = 8192
DEPTH = 2

CTX_LEN = 256
GRID_W = 64
EPS = 1e-6

NA_HEADS = 8
NA_HEAD_DIM = 64
NA_WIN_H = 8
NA_WIN_W = 16
SSM_HEADS = 4
SSM_HEAD_DIM = 64
SSM_GROUPS = 2
SSM_STATE = 128
SSM_CONV = 5
SSM_CHUNK = 128
ML_HEADS = 4
ML_HEAD_DIM = 64
ML_CHUNK = 128
ROPE_THETA = 10000.0
N_EXPERTS = 32
TOP_K = 4
D_FF = 1024
SWIGLU_ALPHA = 1.702
SWIGLU_LIMIT = 7.0

NA_WIDTH = NA_HEADS * NA_HEAD_DIM
SSM_WIDTH = SSM_HEADS * SSM_HEAD_DIM
SSM_BC = SSM_GROUPS * SSM_STATE
SSM_CONV_CH = SSM_WIDTH + 2 * SSM_BC
ML_WIDTH = ML_HEADS * ML_HEAD_DIM
D_MIX = NA_WIDTH + SSM_WIDTH + ML_WIDTH
IN_SPLITS = (NA_WIDTH, NA_WIDTH, NA_WIDTH, SSM_CONV_CH, SSM_WIDTH, 2 * SSM_HEADS,
             ML_WIDTH, ML_WIDTH, ML_WIDTH, ML_WIDTH, 2 * ML_HEADS, 2 * ML_HEADS)
IN_OFFSETS = tuple(int(o) for o in np.cumsum(IN_SPLITS)[:-1])
D_IN = sum(IN_SPLITS)

kernel_name = "hybrid_natten_ssd_mlstm_moe_dit"


def rms_norm(x, g):
    xf = x.astype(jnp.float32)
    y = xf * lax.rsqrt(jnp.mean(xf * xf, axis=-1, keepdims=True) + EPS)
    return (y * g.astype(jnp.float32)).astype(x.dtype)


def modulate(x, shift, scale):
    return x * (1 + scale) + shift


def ada_params(cond, w, b):
    mod = jax.nn.silu(cond) @ w + b
    return [m[..., None, :] for m in jnp.split(mod, 6, axis=-1)]


def split_heads(t, n_heads):
    return t.reshape(t.shape[0], t.shape[1], n_heads, -1)


def orient(t, flip):
    return jnp.flip(t, axis=1) if flip else t


def to_chunks(t, size):
    return t.reshape((t.shape[0], t.shape[1] // size, size) + t.shape[2:]).astype(jnp.float32)


def tri_mask(n):
    return jnp.tril(jnp.ones((n, n), dtype=bool))


def axial_rope(n_tokens, head_dim):
    pos = jnp.arange(n_tokens, dtype=jnp.int32)
    row = (pos // GRID_W).astype(jnp.float32)
    col = (pos % GRID_W).astype(jnp.float32)
    n_freq = head_dim // 4
    inv_freq = ROPE_THETA ** (-jnp.arange(n_freq, dtype=jnp.float32) / n_freq)
    ang = jnp.concatenate([row[:, None] * inv_freq, col[:, None] * inv_freq], axis=-1)
    return jnp.cos(ang), jnp.sin(ang)


def apply_rope(x, cos, sin):
    xf = x.astype(jnp.float32)
    x1, x2 = jnp.split(xf, 2, axis=-1)
    cos = cos[None, :, None, :]
    sin = sin[None, :, None, :]
    return jnp.concatenate([x1 * cos - x2 * sin, x1 * sin + x2 * cos], axis=-1).astype(x.dtype)


def window_starts(n, win):
    pos = jnp.arange(n, dtype=jnp.int32)
    return jnp.clip(pos - win // 2, 0, n - win)


def neighborhood_attention(q, k, v, k_ctx, v_ctx, rpb, rows):
    bsz, L, H, d = q.shape
    win_h = min(NA_WIN_H, rows)
    scale = d ** -0.5
    kg = k.reshape(bsz, rows, GRID_W, H, d)
    vg = v.reshape(bsz, rows, GRID_W, H, d)
    q_rows = jnp.moveaxis(q.reshape(bsz, rows, GRID_W, H, d), 1, 0)
    row_start = window_starts(rows, win_h)
    col_idx = window_starts(GRID_W, NA_WIN_W)[:, None] + jnp.arange(NA_WIN_W, dtype=jnp.int32)
    dc = col_idx - jnp.arange(GRID_W, dtype=jnp.int32)[:, None] + (NA_WIN_W - 1)
    n_win = win_h * NA_WIN_W

    def one_row(args):
        q_r, r, r0 = args
        k_win = lax.dynamic_slice_in_dim(kg, r0, win_h, axis=1)[:, :, col_idx]
        v_win = lax.dynamic_slice_in_dim(vg, r0, win_h, axis=1)[:, :, col_idx]
        dr = r0 + jnp.arange(win_h, dtype=jnp.int32) - r + (NA_WIN_H - 1)
        bias = rpb[:, dr[:, None, None], dc[None]]
        s_win = (jnp.einsum('bqhd,brqwhd->bhqrw', q_r, k_win).astype(jnp.float32) * scale
                 + jnp.transpose(bias, (0, 2, 1, 3)).astype(jnp.float32))
        s_ctx = jnp.einsum('bqhd,bkhd->bhqk', q_r, k_ctx).astype(jnp.float32) * scale
        s = jnp.concatenate([s_win.reshape(bsz, H, GRID_W, n_win), s_ctx], axis=-1)
        p = jax.nn.softmax(s, axis=-1).astype(v.dtype)
        p_win = p[..., :n_win].reshape(bsz, H, GRID_W, win_h, NA_WIN_W)
        return (jnp.einsum('bhqrw,brqwhd->bqhd', p_win, v_win)
                + jnp.einsum('bhqk,bkhd->bqhd', p[..., n_win:], v_ctx))

    out = lax.map(one_row, (q_rows, jnp.arange(rows, dtype=jnp.int32), row_start))
    return jnp.moveaxis(out, 0, 1).reshape(bsz, L, H, d)


def context_attention(q, k, v):
    scale = q.shape[-1] ** -0.5
    s = jnp.einsum('bqhd,bkhd->bhqk', q, k).astype(jnp.float32) * scale
    p = jax.nn.softmax(s, axis=-1).astype(v.dtype)
    return jnp.einsum('bhqk,bkhd->bqhd', p, v)


def depthwise_conv(x, w, b):
    y = lax.conv_general_dilated(x, w[:, None, :], window_strides=(1,),
                                 padding=[(SSM_CONV // 2, SSM_CONV // 2)],
                                 dimension_numbers=('NWC', 'WIO', 'NWC'),
                                 feature_group_count=x.shape[-1])
    return y + b


def mamba2_inputs(xbc, dt_raw, conv_w, conv_b, dt_bias):
    bsz, L, _ = xbc.shape
    xbc = jax.nn.silu(depthwise_conv(xbc, conv_w, conv_b))
    xs, bm, cm = jnp.split(xbc, (SSM_WIDTH, SSM_WIDTH + SSM_BC), axis=-1)
    rep = SSM_HEADS // SSM_GROUPS
    bm = jnp.repeat(bm.reshape(bsz, L, SSM_GROUPS, SSM_STATE), rep, axis=2)
    cm = jnp.repeat(cm.reshape(bsz, L, SSM_GROUPS, SSM_STATE), rep, axis=2)
    dt = jax.nn.softplus(dt_raw.reshape(bsz, L, 2, SSM_HEADS).astype(jnp.float32)
                         + dt_bias.astype(jnp.float32))
    return xs.reshape(bsz, L, SSM_HEADS, SSM_HEAD_DIM), bm, cm, dt


def ssd_scan(xs, dt, a_coef, bm, cm, h0, need_y):
    bsz, L, H, P = xs.shape
    xc, bc, cc, dtc = (to_chunks(t, SSM_CHUNK) for t in (xs, bm, cm, dt))
    la = jnp.swapaxes(dtc * a_coef.astype(jnp.float32), 2, 3)
    acum = jnp.cumsum(la, axis=-1)
    xdt = xc * dtc[..., None]
    states = jnp.einsum('bchq,bcqhn,bcqhp->bchpn', jnp.exp(acum[..., -1:] - acum), bc, xdt)
    decay = jnp.exp(acum[..., -1])

    def step(h, inp):
        s, g = inp
        return g[..., None, None] * h + s, h

    h_final, h_in = lax.scan(step, h0, (jnp.moveaxis(states, 1, 0), jnp.moveaxis(decay, 1, 0)))
    if not need_y:
        return None, h_final
    h_in = jnp.moveaxis(h_in, 0, 1)
    lmat = jnp.exp(jnp.where(tri_mask(SSM_CHUNK), acum[..., :, None] - acum[..., None, :], -jnp.inf))
    scores = jnp.einsum('bcihn,bcjhn->bchij', cc, bc) * lmat
    y = jnp.einsum('bchij,bcjhp->bcihp', scores, xdt)
    y = y + jnp.einsum('bcihn,bchpn->bcihp', cc, h_in) * jnp.swapaxes(jnp.exp(acum), 2, 3)[..., None]
    return y.reshape(bsz, L, H, P), h_final


def ssd_bidirectional(lat, ctx, a_log, d_skip, ctx_out):
    a_coef = -jnp.exp(a_log.astype(jnp.float32))
    bsz = lat[0].shape[0]
    outs_l, outs_c = [], []
    for direction in range(2):
        flip = direction == 1
        xs_c, b_c, c_c, dt_c = (orient(t, flip) for t in ctx)
        xs_l, b_l, c_l, dt_l = (orient(t, flip) for t in lat)
        h0 = jnp.zeros((bsz, SSM_HEADS, SSM_HEAD_DIM, SSM_STATE), jnp.float32)
        y_c, h_c = ssd_scan(xs_c, dt_c[:, :, direction], a_coef[direction], b_c, c_c, h0, ctx_out)
        y_l, _ = ssd_scan(xs_l, dt_l[:, :, direction], a_coef[direction], b_l, c_l, h_c, True)
        skip = d_skip[direction].astype(jnp.float32)[:, None]
        outs_l.append(orient(y_l, flip) + lat[0].astype(jnp.float32) * skip)
        if ctx_out:
            outs_c.append(orient(y_c, flip) + ctx[0].astype(jnp.float32) * skip)
    y_ctx = outs_c[0] + outs_c[1] if ctx_out else None
    return outs_l[0] + outs_l[1], y_ctx


def mlstm_gate_logs(i_raw, f_raw, gate_b):
    bsz, L, _ = i_raw.shape
    li = i_raw.reshape(bsz, L, 2, ML_HEADS).astype(jnp.float32) + gate_b[:, 0].astype(jnp.float32)
    lf = jax.nn.log_sigmoid(f_raw.reshape(bsz, L, 2, ML_HEADS).astype(jnp.float32)
                            + gate_b[:, 1].astype(jnp.float32))
    return li, lf


def mlstm_scan(q, k, v, li, lf, state0, need_h):
    bsz, L, H, d = q.shape
    qc = to_chunks(q, ML_CHUNK) * d ** -0.5
    kc, vc = to_chunks(k, ML_CHUNK), to_chunks(v, ML_CHUNK)
    li_c = jnp.swapaxes(to_chunks(li, ML_CHUNK), 2, 3)
    bcum = jnp.cumsum(jnp.swapaxes(to_chunks(lf, ML_CHUNK), 2, 3), axis=-1)
    g = bcum[..., -1]
    w_end = g[..., None] - bcum + li_c
    m_loc = jnp.max(w_end, axis=-1)
    e_end = jnp.exp(w_end - m_loc[..., None])
    c_loc = jnp.einsum('bchj,bcjhe,bcjhd->bched', e_end, vc, kc)
    n_loc = jnp.einsum('bchj,bcjhd->bchd', e_end, kc)

    def step(state, inp):
        C, n, m = state
        cl, nl, ml, gc = inp
        m_new = jnp.maximum(gc + m, ml)
        a_old = jnp.exp(gc + m - m_new)
        a_new = jnp.exp(ml - m_new)
        return ((a_old[..., None, None] * C + a_new[..., None, None] * cl,
                 a_old[..., None] * n + a_new[..., None] * nl, m_new), (C, n, m))

    final, (c_in, n_in, m_in) = lax.scan(
        step, state0, tuple(jnp.moveaxis(t, 1, 0) for t in (c_loc, n_loc, m_loc, g)))
    if not need_h:
        return None, final
    c_in, n_in, m_in = (jnp.moveaxis(t, 0, 1) for t in (c_in, n_in, m_in))
    log_d = jnp.where(tri_mask(ML_CHUNK),
                      bcum[..., :, None] - bcum[..., None, :] + li_c[..., None, :], -jnp.inf)
    log_inter = bcum + m_in[..., None]
    m_i = jnp.maximum(jnp.max(log_d, axis=-1), log_inter)
    s = jnp.einsum('bcihd,bcjhd->bchij', qc, kc) * jnp.exp(log_d - m_i[..., None])
    inter = jnp.swapaxes(jnp.exp(log_inter - m_i), 2, 3)
    num = (jnp.einsum('bchij,bcjhe->bcihe', s, vc)
           + jnp.einsum('bched,bcihd->bcihe', c_in, qc) * inter[..., None])
    den = (jnp.swapaxes(jnp.sum(s, axis=-1), 2, 3)
           + jnp.einsum('bchd,bcihd->bcih', n_in, qc) * inter)
    floor = jnp.swapaxes(jnp.exp(-m_i), 2, 3)
    h = num / jnp.maximum(jnp.abs(den), floor)[..., None]
    return h.reshape(bsz, L, H, d), final


def mlstm_bidirectional(lat, ctx, ctx_out):
    bsz = lat[0].shape[0]
    outs_l, outs_c = [], []
    for direction in range(2):
        flip = direction == 1
        q_c, k_c, v_c, li_c, lf_c = (orient(t, flip) for t in ctx)
        q_l, k_l, v_l, li_l, lf_l = (orient(t, flip) for t in lat)
        state0 = (jnp.zeros((bsz, ML_HEADS, ML_HEAD_DIM, ML_HEAD_DIM), jnp.float32),
                  jnp.zeros((bsz, ML_HEADS, ML_HEAD_DIM), jnp.float32),
                  jnp.zeros((bsz, ML_HEADS), jnp.float32))
        h_c, s_c = mlstm_scan(q_c, k_c, v_c, li_c[:, :, direction], lf_c[:, :, direction], state0, ctx_out)
        h_l, _ = mlstm_scan(q_l, k_l, v_l, li_l[:, :, direction], lf_l[:, :, direction], s_c, True)
        outs_l.append(orient(h_l, flip))
        if ctx_out:
            outs_c.append(orient(h_c, flip))
    h_ctx = outs_c[0] + outs_c[1] if ctx_out else None
    return outs_l[0] + outs_l[1], h_ctx


def merge_groups(ya, yb, z, yc, o, ssm_g, ml_g, w_out):
    bsz, L = ya.shape[:2]
    dtype = z.dtype
    yb = rms_norm(yb.reshape(bsz, L, SSM_WIDTH).astype(dtype) * jax.nn.silu(z), ssm_g)
    yc = jax.nn.sigmoid(o).reshape(bsz, L, ML_HEADS, ML_HEAD_DIM) * yc.astype(dtype)
    yc = rms_norm(yc, ml_g.reshape(ML_HEADS, ML_HEAD_DIM)).reshape(bsz, L, ML_WIDTH)
    return jnp.concatenate([ya.reshape(bsz, L, NA_WIDTH), yb, yc], axis=-1) @ w_out


def token_mixer(u_l, u_c, w_in, qk_g, rpb, conv_w, conv_b, dt_bias, a_log, d_skip, ssm_g,
                ml_gate_b, ml_g, w_out, rope_cos, rope_sin, rows, ctx_out):
    pl = jnp.split(u_l @ w_in, IN_OFFSETS, axis=-1)
    pc = jnp.split(u_c @ w_in, IN_OFFSETS, axis=-1)

    qa_l = rms_norm(split_heads(pl[0], NA_HEADS), qk_g[0])
    ka_l = rms_norm(split_heads(pl[1], NA_HEADS), qk_g[1])
    va_l = split_heads(pl[2], NA_HEADS)
    ka_c = rms_norm(split_heads(pc[1], NA_HEADS), qk_g[1])
    va_c = split_heads(pc[2], NA_HEADS)
    ya_l = neighborhood_attention(qa_l, ka_l, va_l, ka_c, va_c, rpb, rows)

    ssm_l = mamba2_inputs(pl[3], pl[5], conv_w, conv_b, dt_bias)
    ssm_c = mamba2_inputs(pc[3], pc[5], conv_w, conv_b, dt_bias)
    yb_l, yb_c = ssd_bidirectional(ssm_l, ssm_c, a_log, d_skip, ctx_out)

    ml_l = (apply_rope(split_heads(pl[6], ML_HEADS), rope_cos, rope_sin),
            apply_rope(split_heads(pl[7], ML_HEADS), rope_cos, rope_sin),
            split_heads(pl[8], ML_HEADS)) + mlstm_gate_logs(pl[10], pl[11], ml_gate_b)
    ml_c = (split_heads(pc[6], ML_HEADS), split_heads(pc[7], ML_HEADS),
            split_heads(pc[8], ML_HEADS)) + mlstm_gate_logs(pc[10], pc[11], ml_gate_b)
    yc_l, yc_c = mlstm_bidirectional(ml_l, ml_c, ctx_out)

    y_l = merge_groups(ya_l, yb_l, pl[4], yc_l, pl[9], ssm_g, ml_g, w_out)
    if not ctx_out:
        return y_l, None
    qa_c = rms_norm(split_heads(pc[0], NA_HEADS), qk_g[0])
    ya_c = context_attention(qa_c, ka_c, va_c)
    y_c = merge_groups(ya_c, yb_c, pc[4], yc_c, pc[9], ssm_g, ml_g, w_out)
    return y_l, y_c


def moe_ffn(t, router_w, router_b, w1, b1, w2, b2):
    logits = (t @ router_w + router_b).astype(jnp.float32)
    top_vals, top_idx = lax.top_k(logits, TOP_K)
    top_w = jax.nn.softmax(top_vals, axis=-1)
    gates = jnp.sum(jax.nn.one_hot(top_idx, N_EXPERTS, dtype=jnp.float32) * top_w[..., None],
                    axis=1).astype(t.dtype)
    out = jnp.zeros_like(t)
    for e in range(N_EXPERTS):
        x_glu, x_lin = jnp.split(t @ w1[e] + b1[e], 2, axis=-1)
        x_glu = jnp.minimum(x_glu, SWIGLU_LIMIT)
        x_lin = jnp.clip(x_lin, -SWIGLU_LIMIT, SWIGLU_LIMIT)
        act = x_glu * jax.nn.sigmoid(SWIGLU_ALPHA * x_glu) * (x_lin + 1)
        out = out + gates[:, e:e + 1] * (act @ w2[e] + b2[e])
    return out


def setup_inputs(seed: int = 0) -> dict:
    key = jax.random.key(seed)
    ks = jax.random.split(key, 26)
    f32 = jnp.float32

    def normal(k, shape, std):
        return jax.random.normal(k, shape, f32) * std

    dt0 = jnp.exp(jax.random.uniform(ks[12], (DEPTH, 2, SSM_HEADS), f32, math.log(1e-3), math.log(1e-1)))
    input_b = normal(ks[16], (DEPTH, 2, ML_HEADS), 0.1)
    forget_b = jnp.linspace(3.0, 6.0, ML_HEADS, dtype=f32) + normal(ks[17], (DEPTH, 2, ML_HEADS), 0.1)
    return {
        "x": normal(ks[0], (BATCH, SEQ, D_MODEL), 1.0),
        "c": normal(ks[1], (BATCH, D_MODEL), 1.0),
        "ctx": normal(ks[2], (BATCH, CTX_LEN, D_MODEL), 1.0),
        "c_ctx": normal(ks[3], (D_MODEL,), 1.0),
        "ada_w": normal(ks[4], (DEPTH, D_MODEL, 6 * D_MODEL), 0.5 * D_MODEL ** -0.5),
        "ada_b": normal(ks[5], (DEPTH, 6 * D_MODEL), 0.1),
        "norm_g": 1.0 + normal(ks[6], (DEPTH, 2, D_MODEL), 0.05),
        "w_in": normal(ks[7], (DEPTH, D_MODEL, D_IN), D_MODEL ** -0.5),
        "na_qk_g": 1.0 + normal(ks[8], (DEPTH, 2, NA_HEAD_DIM), 0.05),
        "na_rpb": normal(ks[9], (DEPTH, NA_HEADS, 2 * NA_WIN_H - 1, 2 * NA_WIN_W - 1), 0.5),
        "ssm_conv_w": normal(ks[10], (DEPTH, SSM_CONV, SSM_CONV_CH), SSM_CONV ** -0.5),
        "ssm_conv_b": normal(ks[11], (DEPTH, SSM_CONV_CH), 0.05),
        "ssm_dt_bias": dt0 + jnp.log(-jnp.expm1(-dt0)),
        "ssm_a_log": jnp.log(jax.random.uniform(ks[13], (DEPTH, 2, SSM_HEADS), f32, 1.0, 16.0)),
        "ssm_d": 1.0 + normal(ks[14], (DEPTH, 2, SSM_HEADS), 0.1),
        "ssm_norm_g": 1.0 + normal(ks[15], (DEPTH, SSM_WIDTH), 0.05),
        "ml_gate_b": jnp.stack([input_b, forget_b], axis=2),
        "ml_norm_g": 1.0 + normal(ks[18], (DEPTH, ML_WIDTH), 0.05),
        "w_out": normal(ks[19], (DEPTH, D_MIX, D_MODEL), D_MIX ** -0.5),
        "router_w": normal(ks[20], (DEPTH, D_MODEL, N_EXPERTS), D_MODEL ** -0.5),
        "router_b": normal(ks[21], (DEPTH, N_EXPERTS), 0.01),
        "exp_w1": normal(ks[22], (DEPTH, N_EXPERTS, D_MODEL, 2 * D_FF), D_MODEL ** -0.5),
        "exp_b1": normal(ks[23], (DEPTH, N_EXPERTS, 2 * D_FF), 0.02),
        "exp_w2": normal(ks[24], (DEPTH, N_EXPERTS, D_FF, D_MODEL), D_FF ** -0.5),
        "exp_b2": normal(ks[25], (DEPTH, N_EXPERTS, D_MODEL), 0.02),
    }


def reference(x, c, ctx, c_ctx, ada_w, ada_b, norm_g, w_in, na_qk_g, na_rpb, ssm_conv_w, ssm_conv_b,
              ssm_dt_bias, ssm_a_log, ssm_d, ssm_norm_g, ml_gate_b, ml_norm_g, w_out,
              router_w, router_b, exp_w1, exp_b1, exp_w2, exp_b2):
    bsz, L, D = x.shape
    n_ctx = ctx.shape[1]
    rows = L // GRID_W
    rope_cos, rope_sin = axial_rope(L, ML_HEAD_DIM)
    h, hc = x, ctx
    for layer in range(DEPTH):
        ctx_out = layer < DEPTH - 1
        sh1, sc1, g1, sh2, sc2, g2 = ada_params(c, ada_w[layer], ada_b[layer])
        sh1c, sc1c, g1c, sh2c, sc2c, g2c = ada_params(c_ctx, ada_w[layer], ada_b[layer])
        u_l = modulate(rms_norm(h, norm_g[layer, 0]), sh1, sc1)
        u_c = modulate(rms_norm(hc, norm_g[layer, 0]), sh1c, sc1c)
        y_l, y_c = token_mixer(u_l, u_c, w_in[layer], na_qk_g[layer], na_rpb[layer],
                               ssm_conv_w[layer], ssm_conv_b[layer], ssm_dt_bias[layer],
                               ssm_a_log[layer], ssm_d[layer], ssm_norm_g[layer],
                               ml_gate_b[layer], ml_norm_g[layer], w_out[layer],
                               rope_cos, rope_sin, rows, ctx_out)
        h = h + g1 * y_l
        moe = (router_w[layer], router_b[layer], exp_w1[layer], exp_b1[layer], exp_w2[layer], exp_b2[layer])
        v_l = modulate(rms_norm(h, norm_g[layer, 1]), sh2, sc2).reshape(bsz * L, D)
        if ctx_out:
            hc = hc + g1c * y_c
            v_c = modulate(rms_norm(hc, norm_g[layer, 1]), sh2c, sc2c).reshape(bsz * n_ctx, D)
            f = moe_ffn(jnp.concatenate([v_l, v_c], axis=0), *moe)
            h = h + g2 * f[: bsz * L].reshape(bsz, L, D)
            hc = hc + g2c * f[bsz * L:].reshape(bsz, n_ctx, D)
        else:
            h = h + g2 * moe_ffn(v_l, *moe).reshape(bsz, L, D)
    return h
```

```cpp
#include <hip/hip_runtime.h>
#include <cstdio>
#include <cstdint>
#ifndef DUP_MASK
#define DUP_MASK 0
#endif
#ifndef DUP6_SUB
#define DUP6_SUB 7
#endif
namespace pg8 {
#define PG8_LAS __attribute__((address_space(3)))
typedef unsigned short bf16_t;
typedef short bf16x8 __attribute__((ext_vector_type(8)));
typedef float f32x4 __attribute__((ext_vector_type(4)));
typedef unsigned u32x4 __attribute__((ext_vector_type(4)));
constexpr int BM = 256, BK = 64, HALF = 128, HTB = HALF * BK * 2  , STAGE_BYTES = 8 * HTB, NXCD = 8, WGM = 8;

__host__ __device__ __forceinline__ int lds_byte(int r, int c) { const int st = (r >> 4) * 2 + (c >> 5), rr = r & 15, cc = c & 31, ob = rr * 64 + cc * 2; return st * 1024 + (ob ^ (((ob >> 9) & 1) << 5)); }
__host__ __device__ __forceinline__ void stage_rc(int b, int& R, int& C) { const int st = b / 1024, sb = b % 1024, swz = sb ^ (((sb >> 9) & 1) << 5); R = (st >> 1) * 16 + swz / 64; C = (st & 1) * 32 + (swz % 64) / 2; }
__host__ __device__ __forceinline__ int perm32(int rho) { const int n = rho >> 4, i = rho & 15; return 8 * (i >> 2) + 4 * n + (i & 3); }

struct Unit { int pm, pn; };
struct Gemm { const bf16_t* A; const bf16_t* Bt; int M, N, K; };

struct StaticOrder {
    int nM, nN, nwg, G, c;
    __host__ __device__ void init(int M, int N, int G_, int c_) { nM = M / BM; nN = N / BM; nwg = nM * nN; G = G_; c = c_; }
    __host__ __device__ bool next(int i, Unit& u) const {
        const long L = (long)i * G + c; if (L >= nwg) return false;
        int wgid = (int)L; { const int q = nwg / NXCD, r = nwg % NXCD, xcd = wgid % NXCD, off = wgid / NXCD; wgid = (xcd < r ? xcd * (q + 1) : r * (q + 1) + (xcd - r) * q) + off; }
        const int nig = WGM * nN, gid = wgid / nig, fm = gid * WGM, gsz = (nM - fm) < WGM ? (nM - fm) : WGM;
        u.pm = fm + ((wgid % nig) % gsz); u.pn = (wgid % nig) / gsz; return true;
    }
    __device__ __forceinline__ void a_ready(const Unit&) const {}
    __device__ __forceinline__ void done(const Unit&) const {}
    __device__ __forceinline__ int arow(const Unit& u, int r) const { return u.pm * BM + r; }
};

__device__ __forceinline__ unsigned cvt_pk_bf16(float lo, float hi) { typedef __bf16 b2 __attribute__((ext_vector_type(2))); typedef float f2 __attribute__((ext_vector_type(2))); f2 v = {lo, hi}; return __builtin_bit_cast(unsigned, __builtin_convertvector(v, b2)); }
typedef int i32x8 __attribute__((ext_vector_type(8)));
typedef int i32x4v __attribute__((ext_vector_type(4)));
__device__ __forceinline__ i32x8 cat8(bf16x8 lo, bf16x8 hi) { return __builtin_shufflevector(__builtin_bit_cast(i32x4v, lo), __builtin_bit_cast(i32x4v, hi), 0, 1, 2, 3, 4, 5, 6, 7); }
__device__ __forceinline__ void mfma8_tied(f32x4& acc, i32x8 a, i32x8 b, int one) { asm volatile("v_mfma_scale_f32_16x16x128_f8f6f4 %0, %1, %2, %0, %3, %3 op_sel_hi:[0,0,0]" : "+v"(acc) : "v"(a), "v"(b), "v"(one)); }
template <class Epi, class Sched, bool ALIGN_EPI = false, bool SP2 = false, bool FP8 = false, bool GATHER = false>
__device__ __forceinline__ void gemm_phase(PG8_LAS unsigned char* lds, const Gemm g, const Sched& S, const Epi& E) {
    int tid_ = threadIdx.x; asm volatile("" : "+v"(tid_));
    const int tid = tid_, wid = __builtin_amdgcn_readfirstlane(tid >> 6), lane = tid & 63, wr = wid >> 2, wc = wid & 3, fr = lane & 15, fq = lane >> 4;
    const int K = g.K, nt = K / BK;
    int one8_ = 0x7f7f7f7f; asm volatile("" : "+v"(one8_));
    unsigned voffA[2], voffB[2];
#pragma unroll
    for (int i = 0; i < 2; ++i) { int R, C; stage_rc(tid * 16 + i * 8192, R, C); const int Rb = Epi::PERM ? ((R & ~31) + perm32(R & 31)) : R;
        voffA[i] = (unsigned)(R * K + C) * 2u; voffB[i] = (unsigned)(Rb * K + C) * 2u; }
    const size_t kstep = (size_t)(BK * 2);
    const size_t hstep = (size_t)HALF * K * 2;
    const size_t tstep = 2 * hstep;
    const unsigned ldsw = (unsigned)wid * 1024u;
    const int aoff = lds_byte(wr * 64 + fr, fq * 8), boff = lds_byte(wc * 32 + fr, fq * 8);
    unsigned va[2][2] = {{0u, 0u}, {0u, 0u}}, vn[2][2] = {{0u, 0u}, {0u, 0u}}; int tk[2][2] = {{0, 0}, {0, 0}};
#define PG8_AROWS(X, unit) do { if constexpr (GATHER) { int t3_ = threadIdx.x; asm volatile("" : "+v"(t3_)); _Pragma("unroll") for (int i_ = 0; i_ < 2; ++i_) { int R_, C_; stage_rc(t3_ * 16 + i_ * 8192, R_, C_); \
        _Pragma("unroll") for (int h_ = 0; h_ < 2; ++h_) X[h_][i_] = S.arow(unit, h_ * HALF + R_); } } } while (0)
#define PG8_AOFFS(X, T) do { if constexpr (GATHER) { int t3_ = threadIdx.x; asm volatile("" : "+v"(t3_)); _Pragma("unroll") for (int i_ = 0; i_ < 2; ++i_) { int R_, C_; stage_rc(t3_ * 16 + i_ * 8192, R_, C_); \
        _Pragma("unroll") for (int h_ = 0; h_ < 2; ++h_) X[h_][i_] = (unsigned)T[h_][i_] * (unsigned)(K * 2) + (unsigned)(C_ * 2); } } } while (0)
#define PG8_SA(b, h) (((b) * 2 + (h)) * HTB)
#define PG8_SB(b, h) ((4 + (b) * 2 + (h)) * HTB)
#define PG8_STAGE(bufoff, gbase, voff) do { _Pragma("unroll") for (int _i = 0; _i < 2; ++_i) \
        __builtin_amdgcn_global_load_lds((const unsigned*)((const char*)(gbase) + (voff)[_i]), (PG8_LAS unsigned*)(lds + (bufoff) + ldsw + _i * 8192), 16, 0, 0); } while (0)
#define PG8_LDA(dst, b, h) do { _Pragma("unroll") for (int m = 0; m < 4; ++m) _Pragma("unroll") for (int k = 0; k < 2; ++k) dst[m][k] = *(const PG8_LAS bf16x8*)(lds + PG8_SA(b, h) + aoff + m * 2048 + k * 1024); } while (0)
#define PG8_LDB(dst, b, h) do { _Pragma("unroll") for (int n = 0; n < 2; ++n) _Pragma("unroll") for (int k = 0; k < 2; ++k) dst[n][k] = *(const PG8_LAS bf16x8*)(lds + PG8_SB(b, h) + boff + n * 2048 + k * 1024); } while (0)
#define PG8_MMA(ai, bj, At, Bt) do { __builtin_amdgcn_s_setprio(1); _Pragma("unroll") for (int m = 0; m < 4; ++m) _Pragma("unroll") for (int n = 0; n < 2; ++n) { \
        if constexpr (FP8) mfma8_tied(acc[ai][bj][m][n], cat8(Bt[n][0], Bt[n][1]), cat8(At[m][0], At[m][1]), one8_); \
        else { _Pragma("unroll") for (int k = 0; k < 2; ++k) acc[ai][bj][m][n] = __builtin_amdgcn_mfma_f32_16x16x32_bf16(Bt[n][k], At[m][k], acc[ai][bj][m][n], 0, 0, 0); } } __builtin_amdgcn_s_setprio(0); } while (0)
#define PG8_WAIT_V(n) asm volatile("s_waitcnt vmcnt(" #n ")" ::: "memory")
#define PG8_WAIT_L(n) asm volatile("s_waitcnt lgkmcnt(" #n ")" ::: "memory")
#define PG8_BAR __builtin_amdgcn_s_barrier()
#define PG8_SCHED __builtin_amdgcn_sched_barrier(0)
    Unit cur, nxt; int ui = 0;
    if (!S.next(0, cur)) return;
    f32x4 acc[2][2][4][2];
#pragma unroll
    for (int a = 0; a < 2; ++a)
#pragma unroll
        for (int b = 0; b < 2; ++b)
#pragma unroll
            for (int m = 0; m < 4; ++m)
#pragma unroll
                for (int n = 0; n < 2; ++n) acc[a][b][m][n] = (f32x4){0.f, 0.f, 0.f, 0.f};
    bf16x8 At[4][2], B0[2][2], B1[2][2];
    const char* cA = (const char*)g.A + (size_t)cur.pm * tstep; const char* cB = (const char*)g.Bt + (size_t)cur.pn * tstep;
    const char* const gA = (const char*)g.A;
    S.a_ready(cur);
    if constexpr (SP2) {
        if constexpr (GATHER) { PG8_AROWS(tk, cur); PG8_AOFFS(va, tk); }
        PG8_STAGE(PG8_SB(0, 0), cB, voffB); PG8_STAGE(PG8_SB(0, 1), cB + hstep, voffB);
        if constexpr (GATHER) { PG8_STAGE(PG8_SA(0, 0), gA, va[0]); PG8_STAGE(PG8_SA(0, 1), gA, va[1]); } else { PG8_STAGE(PG8_SA(0, 0), cA, voffA); PG8_STAGE(PG8_SA(0, 1), cA + hstep, voffA); }
        if (wr == 1) PG8_BAR;
        PG8_WAIT_V(2); PG8_BAR;
        PG8_STAGE(PG8_SB(1, 0), cB + kstep, voffB); if constexpr (GATHER) PG8_STAGE(PG8_SA(1, 0), gA + kstep, va[0]); else PG8_STAGE(PG8_SA(1, 0), cA + kstep, voffA); PG8_STAGE(PG8_SB(1, 1), cB + hstep + kstep, voffB);
        PG8_WAIT_V(6); PG8_BAR;
    } else {
        PG8_STAGE(PG8_SB(0, 0), cB, voffB); PG8_STAGE(PG8_SA(0, 0), cA, voffA); PG8_STAGE(PG8_SB(0, 1), cB + hstep, voffB); PG8_STAGE(PG8_SA(0, 1), cA + hstep, voffA);
        if (wr == 1) PG8_BAR;
        PG8_WAIT_V(4); PG8_BAR;
        PG8_STAGE(PG8_SB(1, 0), cB + kstep, voffB); PG8_STAGE(PG8_SA(1, 0), cA + kstep, voffA); PG8_STAGE(PG8_SB(1, 1), cB + hstep + kstep, voffB);
        PG8_WAIT_V(6); PG8_BAR;
    }
    for (;;) {
        const bool has_next = S.next(ui + 1, nxt);
        const char* nA = has_next ? (const char*)g.A + (size_t)nxt.pm * tstep : cA; const char* nB = has_next ? (const char*)g.Bt + (size_t)nxt.pn * tstep : cB;
#pragma nounroll
        for (int t = 0; t < nt; t += 2) {
            const bool last = (t == nt - 2);
            const char* a1 = cA + (size_t)(t + 1) * kstep;
            const char* a2 = last ? nA : cA + (size_t)(t + 2) * kstep; const char* b2 = last ? nB : cB + (size_t)(t + 2) * kstep;
            const char* a3 = a2 + kstep; const char* b3 = b2 + kstep;
            if (last && has_next) S.a_ready(nxt);
            if constexpr (GATHER) { if (t == 0 && has_next) PG8_AROWS(tk, nxt); if (last) { if (has_next) PG8_AOFFS(vn, tk); else { vn[0][0] = va[0][0]; vn[0][1] = va[0][1]; vn[1][0] = va[1][0]; vn[1][1] = va[1][1]; } } }
            const char* g1 = gA + (size_t)(t + 1) * kstep; const char* g2 = gA + (last ? 0 : (size_t)(t + 2) * kstep); const char* g3 = g2 + kstep;
            unsigned o0[2] = {last ? vn[0][0] : va[0][0], last ? vn[0][1] : va[0][1]}, o1[2] = {last ? vn[1][0] : va[1][0], last ? vn[1][1] : va[1][1]};
            if constexpr (SP2) {
            PG8_LDB(B0, 0, 0); PG8_LDB(B1, 0, 1); PG8_SCHED; PG8_LDA(At, 0, 0); if constexpr (GATHER) PG8_STAGE(PG8_SA(1, 1), g1, va[1]); else PG8_STAGE(PG8_SA(1, 1), a1 + hstep, voffA);
            PG8_WAIT_V(8); PG8_WAIT_L(0); PG8_BAR; PG8_MMA(0, 0, At, B0); PG8_MMA(0, 1, At, B1); PG8_BAR; PG8_SCHED;
            PG8_LDA(At, 0, 1); PG8_STAGE(PG8_SB(0, 0), b2, voffB); PG8_STAGE(PG8_SB(0, 1), b2 + hstep, voffB); if constexpr (GATHER) PG8_STAGE(PG8_SA(0, 0), g2, o0); else PG8_STAGE(PG8_SA(0, 0), a2, voffA);
            PG8_WAIT_V(8); PG8_WAIT_L(0); PG8_BAR; PG8_MMA(1, 0, At, B0); PG8_MMA(1, 1, At, B1); PG8_BAR; PG8_SCHED;
            PG8_LDB(B0, 1, 0); PG8_LDB(B1, 1, 1); PG8_SCHED; PG8_LDA(At, 1, 0); if constexpr (GATHER) PG8_STAGE(PG8_SA(0, 1), g2, o1); else PG8_STAGE(PG8_SA(0, 1), a2 + hstep, voffA);
            PG8_WAIT_V(8); PG8_WAIT_L(0); PG8_BAR; PG8_MMA(0, 0, At, B0); PG8_MMA(0, 1, At, B1); PG8_BAR; PG8_SCHED;
            PG8_LDA(At, 1, 1); PG8_STAGE(PG8_SB(1, 0), b3, voffB); PG8_STAGE(PG8_SB(1, 1), b3 + hstep, voffB); if constexpr (GATHER) PG8_STAGE(PG8_SA(1, 0), g3, o0); else PG8_STAGE(PG8_SA(1, 0), a3, voffA);
            PG8_WAIT_V(8); PG8_WAIT_L(0); PG8_BAR; PG8_MMA(1, 0, At, B0); PG8_MMA(1, 1, At, B1); PG8_BAR; PG8_SCHED;
            } else {
            PG8_LDB(B0, 0, 0); PG8_SCHED; PG8_LDA(At, 0, 0); PG8_STAGE(PG8_SA(1, 1), a1 + hstep, voffA);
            PG8_WAIT_L(8); PG8_BAR; PG8_WAIT_L(0); PG8_MMA(0, 0, At, B0); PG8_BAR; PG8_SCHED;
            PG8_LDB(B1, 0, 1); PG8_STAGE(PG8_SB(0, 0), b2, voffB);
            PG8_BAR; PG8_WAIT_L(0); PG8_MMA(0, 1, At, B1); PG8_BAR;
            PG8_LDA(At, 0, 1); PG8_STAGE(PG8_SA(0, 0), a2, voffA);
            PG8_BAR; PG8_WAIT_L(0); PG8_MMA(1, 0, At, B0); PG8_BAR; PG8_SCHED;
            PG8_STAGE(PG8_SB(0, 1), b2 + hstep, voffB);
            PG8_WAIT_V(6); PG8_BAR; PG8_MMA(1, 1, At, B1); PG8_BAR;
            PG8_LDB(B0, 1, 0); PG8_SCHED; PG8_LDA(At, 1, 0); PG8_STAGE(PG8_SA(0, 1), a2 + hstep, voffA);
            PG8_WAIT_L(8); PG8_BAR; PG8_WAIT_L(0); PG8_MMA(0, 0, At, B0); PG8_BAR; PG8_SCHED;
            PG8_LDB(B1, 1, 1); PG8_STAGE(PG8_SB(1, 0), b3, voffB);
            PG8_BAR; PG8_WAIT_L(0); PG8_MMA(0, 1, At, B1); PG8_BAR;
            PG8_LDA(At, 1, 1); PG8_STAGE(PG8_SA(1, 0), a3, voffA);
            PG8_BAR; PG8_WAIT_L(0); PG8_MMA(1, 0, At, B0); PG8_BAR; PG8_SCHED;
            PG8_STAGE(PG8_SB(1, 1), b3 + hstep, voffB);
            PG8_WAIT_V(6); PG8_BAR; PG8_MMA(1, 1, At, B1); PG8_BAR;
            }
        }
        if constexpr (ALIGN_EPI) { if (wr == 0) PG8_BAR; }
        if constexpr (!Epi::AFTER_DRAIN) { int t2_ = threadIdx.x; asm volatile("" : "+v"(t2_)); const int l2_ = t2_ & 63;
            E(acc, cur, wr, wc, l2_ & 15, l2_ >> 4); S.done(cur); }
        if (!has_next) break;
#pragma unroll
        for (int a = 0; a < 2; ++a)
#pragma unroll
            for (int b = 0; b < 2; ++b)
#pragma unroll
                for (int m = 0; m < 4; ++m)
#pragma unroll
                    for (int n = 0; n < 2; ++n) acc[a][b][m][n] = (f32x4){0.f, 0.f, 0.f, 0.f};
        cur = nxt; cA = nA; cB = nB; ++ui;
        if constexpr (GATHER) { va[0][0] = vn[0][0]; va[0][1] = vn[0][1]; va[1][0] = vn[1][0]; va[1][1] = vn[1][1]; }
        if constexpr (ALIGN_EPI) { if (wr == 1) PG8_BAR; }
    }
    PG8_WAIT_V(0);
    if constexpr (!ALIGN_EPI) { if (wr == 0) PG8_BAR; }
    PG8_BAR;
    if constexpr (Epi::AFTER_DRAIN) { E.fused(acc, cur, wr, wc, fr, fq, lds, wid, lane); S.done(cur); }
#undef PG8_SA
#undef PG8_AROWS
#undef PG8_AOFFS
#undef PG8_SB
#undef PG8_STAGE
#undef PG8_LDA
#undef PG8_LDB
#undef PG8_MMA
#undef PG8_WAIT_V
#undef PG8_WAIT_L
#undef PG8_BAR
#undef PG8_SCHED
}
}

constexpr int D = 1024, NB = 4, SEQ = 8192, CTXL = 256, NLAT = NB * SEQ, NCTX = NB * CTXL, NTOK = NLAT + NCTX, DEPTH = 2;
constexpr int NPROJ = 3584, NPAD = 3840, DIN = 3608;
constexpr int C_NAQ = 0, C_NAK = 512, C_NAV = 1024, C_XBC = 1536, C_Z = 2304, C_MLQ = 2560, C_MLK = 2816, C_MLV = 3072, C_MLO = 3328;
constexpr int NSC = 66;
constexpr int NEXP = 32;
constexpr int MPAD = 143360, MAXTILES = 560;
constexpr float EPS = 1e-6f, LOG2E = 1.4426950408889634f;
constexpr int NWAVES = 8, NTHR = 512;
constexpr int NPHASES = 23;
constexpr float W8_SCALE = 32.f, W8_INV = 1.f / 32.f;

constexpr size_t MiB = 1u << 20;
constexpr size_t WS_CTL = 0, CTL_ZERO_BYTES = 1 * MiB;
constexpr size_t WS_MOD = 1 * MiB, WS_ROPE = 2 * MiB, WS_WIN = 4 * MiB, WS_WOUT = 20 * MiB, WS_W1 = 24 * MiB, WS_W2 = 280 * MiB;
constexpr size_t WS_H = 408 * MiB, WS_U = 540 * MiB, WS_PROJ = 606 * MiB, WS_GATES = 837 * MiB, WS_SST = 842 * MiB, WS_MC = 908 * MiB, WS_MISC = 941 * MiB;
constexpr size_t WS_MIX = 943 * MiB, WS_XP = 1009 * MiB, WS_ACT = 1289 * MiB, WS_ROUTE = 1569 * MiB, WS_SSTB = 1573 * MiB, WS_MCB = 1607 * MiB, WS_END = 1624 * MiB;
constexpr size_t WS_RWT = 1 * MiB + 512 * 1024;
constexpr int NSIDX = NB * 2 * 4 * NSC;
constexpr int CW_BAR = 4096, CW_CNT = 131072;
constexpr int LDS_BYTES = 147456, MISC_OFF = 147200, LDS_TILE_OFF = 131072;

#define DI __device__ __forceinline__
#define LAS __attribute__((address_space(3)))
typedef unsigned short bf16;
typedef short bf16x8 __attribute__((ext_vector_type(8)));
typedef short s16x4 __attribute__((ext_vector_type(4)));
typedef float f32x4 __attribute__((ext_vector_type(4)));
typedef float f32x2 __attribute__((ext_vector_type(2)));
typedef unsigned u32x4 __attribute__((ext_vector_type(4)));
typedef unsigned u32x2 __attribute__((ext_vector_type(2)));

DI unsigned pk2(float lo, float hi) { typedef __bf16 b2 __attribute__((ext_vector_type(2))); f32x2 v = {lo, hi}; return __builtin_bit_cast(unsigned, __builtin_convertvector(v, b2)); }
DI unsigned pk4_fp8(float a, float b, float c2, float d) { int w = __builtin_amdgcn_cvt_pk_fp8_f32(a, b, 0, false); w = __builtin_amdgcn_cvt_pk_fp8_f32(c2, d, w, true); return (unsigned)w; }
DI f32x4 fp8x4_to_f32(unsigned w) { typedef float f2 __attribute__((ext_vector_type(2))); const f2 lo = __builtin_amdgcn_cvt_pk_f32_fp8((int)w, false), hi = __builtin_amdgcn_cvt_pk_f32_fp8((int)w, true); return (f32x4){lo.x, lo.y, hi.x, hi.y}; }
DI float bflo(unsigned u) { return __uint_as_float(u << 16); }
DI float bfhi(unsigned u) { return __uint_as_float(u & 0xffff0000u); }
DI float bf2f(unsigned short h) { return __uint_as_float(((unsigned)h) << 16); }
#define DPP_F(v, ctrl) __builtin_bit_cast(float, __builtin_amdgcn_update_dpp(0, __builtin_bit_cast(int, v), ctrl, 0xF, 0xF, false))
DI float rl_f(float v, int lane) { return __builtin_bit_cast(float, __builtin_amdgcn_readlane(__builtin_bit_cast(int, v), lane)); }
DI float wave_sum(float v) {
    v += DPP_F(v, 0xB1); v += DPP_F(v, 0x4E); v += DPP_F(v, 0x141); v += DPP_F(v, 0x140);
    return (rl_f(v, 0) + rl_f(v, 16)) + (rl_f(v, 32) + rl_f(v, 48));
}
DI float wave_max(float v) {
    v = fmaxf(v, DPP_F(v, 0xB1)); v = fmaxf(v, DPP_F(v, 0x4E)); v = fmaxf(v, DPP_F(v, 0x141)); v = fmaxf(v, DPP_F(v, 0x140));
    return fmaxf(fmaxf(rl_f(v, 0), rl_f(v, 16)), fmaxf(rl_f(v, 32), rl_f(v, 48)));
}
#define DPP_FI(v, ctrl, ident) __builtin_bit_cast(float, __builtin_amdgcn_update_dpp(__builtin_bit_cast(int, (float)(ident)), __builtin_bit_cast(int, v), ctrl, 0xF, 0xF, false))
DI float scan_add(float s, int lane) {
    s += DPP_FI(s, 0x111, 0.f); s += DPP_FI(s, 0x112, 0.f); s += DPP_FI(s, 0x114, 0.f); s += DPP_FI(s, 0x118, 0.f);
    const float t0 = rl_f(s, 15), t1 = rl_f(s, 31), t2 = rl_f(s, 47);
    return s + (lane >= 16 ? t0 : 0.f) + (lane >= 32 ? t1 : 0.f) + (lane >= 48 ? t2 : 0.f);
}
DI float scan_max(float s, int lane) {
    s = fmaxf(s, DPP_FI(s, 0x111, -INFINITY)); s = fmaxf(s, DPP_FI(s, 0x112, -INFINITY)); s = fmaxf(s, DPP_FI(s, 0x114, -INFINITY)); s = fmaxf(s, DPP_FI(s, 0x118, -INFINITY));
    const float t0 = rl_f(s, 15), t1 = rl_f(s, 31), t2 = rl_f(s, 47);
    return fmaxf(fmaxf(s, lane >= 16 ? t0 : -INFINITY), fmaxf(lane >= 32 ? t1 : -INFINITY, lane >= 48 ? t2 : -INFINITY));
}
DI void swap16(float& a, float& b) { asm volatile("s_nop 1\n\tv_permlane16_swap_b32 %0, %1" : "+v"(a), "+v"(b)); }
DI void swap16u(unsigned& a, unsigned& b) { asm volatile("s_nop 1\n\tv_permlane16_swap_b32 %0, %1" : "+v"(a), "+v"(b)); }
DI u32x4 widen16(u32x2 A, u32x2 B) { unsigned a0 = A.x, a1 = A.y, b0 = B.x, b1 = B.y; swap16u(a0, b0); swap16u(a1, b1); return (u32x4){a0, a1, b0, b1}; }
DI void narrow16(u32x4 w, u32x2& A, u32x2& B) { unsigned a0 = w.x, a1 = w.y, b0 = w.z, b1 = w.w; swap16u(a0, b0); swap16u(a1, b1); A.x = a0; A.y = a1; B.x = b0; B.y = b1; }
DI void swap32(float& a, float& b) { asm volatile("s_nop 1\n\tv_permlane32_swap_b32 %0, %1" : "+v"(a), "+v"(b)); }
DI float col4_sum(float v) { float a = v, b = v; swap16(a, b); v = a + b; a = v; b = v; swap32(a, b); return a + b; }
DI float col4_max(float v) { float a = v, b = v; swap16(a, b); v = fmaxf(a, b); a = v; b = v; swap32(a, b); return fmaxf(a, b); }
DI float sum8_dpp(float v) {
    v += __builtin_bit_cast(float, __builtin_amdgcn_update_dpp(0, __builtin_bit_cast(int, v), 0xB1, 0xF, 0xF, false));
    v += __builtin_bit_cast(float, __builtin_amdgcn_update_dpp(0, __builtin_bit_cast(int, v), 0x4E, 0xF, 0xF, false));
    v += __builtin_bit_cast(float, __builtin_amdgcn_update_dpp(0, __builtin_bit_cast(int, v), 0x141, 0xF, 0xF, false));
    return v;
}
DI float siluf(float x) { return x * __builtin_amdgcn_rcpf(1.f + __expf(-x)); }
DI float sigmf(float x) { return __builtin_amdgcn_rcpf(1.f + __expf(-x)); }
DI float softplusf(float x) { return fmaxf(x, 0.f) + __logf(1.f + __expf(-fabsf(x))); }
DI float logsigf(float x) { return fminf(x, 0.f) - __logf(1.f + __expf(-fabsf(x))); }
DI f32x4 mfma16(bf16x8 a, bf16x8 b, f32x4 c) { return __builtin_amdgcn_mfma_f32_16x16x32_bf16(a, b, c, 0, 0, 0); }
DI bf16x8 frag_kc(const LAS bf16* base, int ld, int r0, int k0, int lane) { return *(const LAS bf16x8*)(base + (r0 + (lane & 15)) * ld + k0 + 8 * (lane >> 4)); }
DI bf16x8 frag_tr(const LAS bf16* base, int ld, int k0, int c0, int lane) {
    const int i16 = lane & 15, q = i16 >> 2, p = i16 & 3, g = lane >> 4;
    const s16x4 lo = __builtin_amdgcn_ds_read_tr16_b64_v4i16((LAS s16x4*)(base + (k0 + 8 * g + q) * ld + c0 + 4 * p));
    const s16x4 hi = __builtin_amdgcn_ds_read_tr16_b64_v4i16((LAS s16x4*)(base + (k0 + 8 * g + 4 + q) * ld + c0 + 4 * p));
    return __builtin_shufflevector(lo, hi, 0, 1, 2, 3, 4, 5, 6, 7);
}
DI bf16x8 frag_trp(const LAS bf16* base, int ld, int k0, int c0, int lane) {
    const int i16 = lane & 15, q = i16 >> 2, p = i16 & 3, g = lane >> 4;
    const s16x4 lo = __builtin_amdgcn_ds_read_tr16_b64_v4i16((LAS s16x4*)(base + (k0 + 4 * g + q) * ld + c0 + 4 * p));
    const s16x4 hi = __builtin_amdgcn_ds_read_tr16_b64_v4i16((LAS s16x4*)(base + (k0 + 16 + 4 * g + q) * ld + c0 + 4 * p));
    return __builtin_shufflevector(lo, hi, 0, 1, 2, 3, 4, 5, 6, 7);
}
DI bf16x8 pack_acc(f32x4 a, f32x4 b) { u32x4 p; p.x = pk2(a.x, a.y); p.y = pk2(a.z, a.w); p.z = pk2(b.x, b.y); p.w = pk2(b.z, b.w); return __builtin_bit_cast(bf16x8, p); }
DI bf16x8 pack8(f32x4 a, f32x4 b) { return pack_acc(a, b); }
DI bf16x8 frag_gf32(const float* base, int ld, int r0, int k0, int lane) {
    const float* p = base + (size_t)(r0 + (lane & 15)) * ld + k0 + 8 * (lane >> 4);
    return pack8(*(const f32x4*)p, *(const f32x4*)(p + 4));
}
DI bf16x8 frag_gbf(const bf16* base, int ld, int r0, int k0, int lane) { return *(const bf16x8*)(base + (size_t)(r0 + (lane & 15)) * ld + k0 + 8 * (lane >> 4)); }
DI bf16x8 scale_frag(bf16x8 f, f32x4 w0, f32x4 w1) {
    const u32x4 u = __builtin_bit_cast(u32x4, f); u32x4 o;
    o.x = pk2(bflo(u.x) * w0.x, bfhi(u.x) * w0.y); o.y = pk2(bflo(u.y) * w0.z, bfhi(u.y) * w0.w);
    o.z = pk2(bflo(u.z) * w1.x, bfhi(u.z) * w1.y); o.w = pk2(bflo(u.w) * w1.z, bfhi(u.w) * w1.w);
    return __builtin_bit_cast(bf16x8, o);
}

struct Args { const float* in[25]; float* out; unsigned char* ws; int ph_lo, ph_hi, li, pad; };
enum { I_X = 0, I_C, I_CTX, I_CCTX, I_ADAW, I_ADAB, I_NORMG, I_WIN, I_QKG, I_RPB, I_CONVW, I_CONVB, I_DTB, I_ALOG, I_SSMD, I_SSMG, I_MLGB, I_MLG, I_WOUT, I_RW, I_RB, I_W1, I_B1, I_W2, I_B2 };

struct Ctx {
    LAS unsigned char* lds; int tid, lane, wave, G;
    unsigned char* ws;
};
#define WSP(T, off) ((T*)(c.ws + (off)))
DI void fresh_ctx(Ctx& c) { int t = threadIdx.x; asm volatile("" : "+v"(t)); c.tid = t; c.lane = t & 63; c.wave = __builtin_amdgcn_readfirstlane(t >> 6); }


DI void phase_ada(const Ctx& c, const Args& a) {
    LAS float* sc = (LAS float*)c.lds;
    LAS float* part = sc + 5 * 1024;
    float* mod = WSP(float, WS_MOD);
    for (int i = c.tid; i < 5 * 1024; i += NTHR) { const int r = i >> 10, k = i & 1023; const float x = r < 4 ? a.in[I_C][r * 1024 + k] : a.in[I_CCTX][k]; sc[i] = siluf(x); }
    __syncthreads();
    for (int item = blockIdx.x; item < 192; item += c.G) {
        const int l = item / 96, j = (item % 96) * 64 + c.lane;
        const float* w = a.in[I_ADAW] + (size_t)l * 1024 * 6144 + j;
        float acc[5] = {0.f, 0.f, 0.f, 0.f, 0.f};
#pragma unroll 8
        for (int kk = 0; kk < 128; ++kk) { const int k = c.wave * 128 + kk; const float wv = __builtin_nontemporal_load(w + (size_t)k * 6144);
#pragma unroll
            for (int r = 0; r < 5; ++r) acc[r] += sc[r * 1024 + k] * wv; }
#pragma unroll
        for (int r = 0; r < 5; ++r) part[(c.wave * 5 + r) * 64 + c.lane] = acc[r];
        __syncthreads();
        if (c.wave == 0) {
#pragma unroll
            for (int r = 0; r < 5; ++r) { float s = 0.f;
#pragma unroll
                for (int w8 = 0; w8 < 8; ++w8) s += part[(w8 * 5 + r) * 64 + c.lane];
                mod[(l * 5 + r) * 6144 + j] = s + a.in[I_ADAB][l * 6144 + j]; }
        }
        __syncthreads();
    }
}

DI int src_col_win(int n) {
    if (n < 1024) { const int p = n & 255; return (n & ~255) + ((p >> 5) & 3) * 64 + (p >> 7) * 32 + (p & 31); }
    return n < 2560 ? n : (n < 3584 ? n + 8 : (n < 3592 ? n - 1024 : (n < 3608 ? n : -1))); }
DI void cvt_tile(const Ctx& c, const float* src, int ldsrc, bf16* dst, int n0, int k0, int mode) {
    LAS unsigned* t = (LAS unsigned*)c.lds;
    const int nq = c.tid & 15, kq = c.tid >> 4, n = n0 + 4 * nq;
    const int scol = mode == 0 ? src_col_win(n) : n;
    f32x4 v[4];
#pragma unroll
    for (int i = 0; i < 4; ++i) v[i] = scol >= 0 ? __builtin_nontemporal_load((const f32x4*)(src + (size_t)(k0 + 4 * kq + i) * ldsrc + scol)) : (f32x4){0.f, 0.f, 0.f, 0.f};
    LAS unsigned* p = t + (4 * nq) * 68 + 2 * kq;
    p[0] = pk2(v[0].x, v[1].x); p[1] = pk2(v[2].x, v[3].x); p[68] = pk2(v[0].y, v[1].y); p[69] = pk2(v[2].y, v[3].y);
    p[136] = pk2(v[0].z, v[1].z); p[137] = pk2(v[2].z, v[3].z); p[204] = pk2(v[0].w, v[1].w); p[205] = pk2(v[2].w, v[3].w);
    __syncthreads();
#pragma unroll
    for (int i = 0; i < 2; ++i) { const int idx = c.tid + NTHR * i, r = idx >> 4, ch = idx & 15;
        *(u32x4*)(dst + (size_t)(n0 + r) * 1024 + k0 + 8 * ch) = *(const LAS u32x4*)(t + r * 68 + 4 * ch); }
    __syncthreads();
}
struct Cvt8Tile { const float* src; unsigned char* dst; int ldsrc, n0, k0, mode; };
DI Cvt8Tile cvt8_decode(const Args& a, unsigned char* w1d, unsigned char* w2d, int r) {
    Cvt8Tile t;
    if (r < 64 * 128) { const int m = r >> 7, q = r & 127; t.src = a.in[I_W1] + (size_t)m * 1024 * 2048; t.ldsrc = 2048; t.dst = w1d + (size_t)m * 2048 * 1024; t.n0 = (q >> 3) * 128; t.k0 = (q & 7) * 128; t.mode = 2; }
    else { r -= 64 * 128; const int m = r >> 6, q = r & 63; t.src = a.in[I_W2] + (size_t)m * 1024 * 1024; t.ldsrc = 1024; t.dst = w2d + (size_t)m * 1024 * 1024; t.n0 = (q >> 3) * 128; t.k0 = (q & 7) * 128; t.mode = 1; }
    return t;
}
DI void cvt8_load(const Ctx& c, const Cvt8Tile& t, f32x4 (&v)[8]) {
    const int nq = c.tid & 31, kq = c.tid >> 5, n = t.n0 + 4 * nq;
    const int scol = t.mode == 1 ? n : (((n & 255) < 128 ? 0 : 1024) + (n >> 8) * 128 + (n & 127));
#pragma unroll
    for (int i = 0; i < 8; ++i) v[i] = __builtin_nontemporal_load((const f32x4*)(t.src + (size_t)(t.k0 + 8 * kq + i) * t.ldsrc + scol));
}
DI void cvt8_store(const Ctx& c, const Cvt8Tile& t, const f32x4 (&v)[8]) {
    LAS unsigned* tl = (LAS unsigned*)c.lds;
    const int nq = c.tid & 31, kq = c.tid >> 5;
#pragma unroll
    for (int hq = 0; hq < 2; ++hq) { LAS unsigned* p = tl + (2 * kq + hq) * 129 + 4 * nq;
        p[0] = pk4_fp8(v[4 * hq].x * W8_SCALE, v[4 * hq + 1].x * W8_SCALE, v[4 * hq + 2].x * W8_SCALE, v[4 * hq + 3].x * W8_SCALE);
        p[1] = pk4_fp8(v[4 * hq].y * W8_SCALE, v[4 * hq + 1].y * W8_SCALE, v[4 * hq + 2].y * W8_SCALE, v[4 * hq + 3].y * W8_SCALE);
        p[2] = pk4_fp8(v[4 * hq].z * W8_SCALE, v[4 * hq + 1].z * W8_SCALE, v[4 * hq + 2].z * W8_SCALE, v[4 * hq + 3].z * W8_SCALE);
        p[3] = pk4_fp8(v[4 * hq].w * W8_SCALE, v[4 * hq + 1].w * W8_SCALE, v[4 * hq + 2].w * W8_SCALE, v[4 * hq + 3].w * W8_SCALE); }
    __syncthreads();
    { const int r = c.tid >> 2, ch = c.tid & 3;
#pragma unroll
      for (int hq = 0; hq < 2; ++hq) { const int cc = ch + 4 * hq; u32x4 o; o.x = tl[(4 * cc + 0) * 129 + r]; o.y = tl[(4 * cc + 1) * 129 + r]; o.z = tl[(4 * cc + 2) * 129 + r]; o.w = tl[(4 * cc + 3) * 129 + r];
          *(u32x4*)(t.dst + (size_t)(t.n0 + r) * 1024 + t.k0 + 16 * cc) = o; } }
    __syncthreads();
}
DI void phase_convert(const Ctx& c, const Args& a) {
    constexpr int T_WIN = 2 * 60 * 8, T_WOUT = 2 * 16 * 8, T_W8 = 64 * 128 + 64 * 64;
    for (int it = blockIdx.x; it < T_WIN + T_WOUT; it += c.G) {
        int r = it;
        if (r < T_WIN) { const int l = r / 480; r %= 480; cvt_tile(c, a.in[I_WIN] + (size_t)l * 1024 * DIN, DIN, WSP(bf16, WS_WIN) + (size_t)l * NPAD * 1024, (r >> 3) * 64, (r & 7) * 128, 0); continue; }
        r -= T_WIN;
        { const int l = r / 128; r %= 128; cvt_tile(c, a.in[I_WOUT] + (size_t)l * 1024 * 1024, 1024, WSP(bf16, WS_WOUT) + (size_t)l * 1024 * 1024, (r >> 3) * 64, (r & 7) * 128, 1); }
    }
    {
        unsigned char* w1d = WSP(unsigned char, WS_W1); unsigned char* w2d = WSP(unsigned char, WS_W2);
        int it = blockIdx.x; f32x4 v[8];
        Cvt8Tile t = cvt8_decode(a, w1d, w2d, it < T_W8 ? it : 0);
        if (it < T_W8) cvt8_load(c, t, v);
        while (it < T_W8) {
            const int nx = it + c.G; f32x4 vn[8]; Cvt8Tile tn = cvt8_decode(a, w1d, w2d, nx < T_W8 ? nx : 0);
            if (nx < T_W8) cvt8_load(c, tn, vn);
            else {
#pragma unroll
                for (int i = 0; i < 8; ++i) vn[i] = v[i]; }
            cvt8_store(c, t, v);
#pragma unroll
            for (int i = 0; i < 8; ++i) v[i] = vn[i];
            t = tn; it = nx;
        }
    }
    for (int idx = blockIdx.x * NTHR + c.tid; idx < 2 * 32 * 1024; idx += c.G * NTHR) {
        const int l = idx >> 15, e = (idx >> 10) & 31, k = idx & 1023; const float w = a.in[I_RW][((size_t)l * 1024 + k) * 32 + e];
        const unsigned hi = pk2(w, 0.f) & 0xffffu; const unsigned lo = pk2(w - bflo(hi), 0.f) & 0xffffu;
        bf16* rwt = WSP(bf16, WS_RWT) + (size_t)l * 2 * 32 * 1024; rwt[e * 1024 + k] = (bf16)hi; rwt[32 * 1024 + e * 1024 + k] = (bf16)lo; }
    float* rc = WSP(float, WS_ROPE); float* rs = rc + 8192 * 32;
    for (int idx = blockIdx.x * NTHR + c.tid; idx < 8192 * 32; idx += c.G * NTHR) {
        const int pos = idx >> 5, f = idx & 31, row = pos >> 6, col = pos & 63;
        const float inv = exp2f(-(float)(f & 15) * (13.287712379549449f / 16.f));
        const float ang = (float)(f < 16 ? row : col) * inv;
        const float k = rintf(ang * 0.15915494309189535f);
        float rr = fmaf(-k, 6.28318548202514648f, ang); rr = fmaf(-k, -1.7484555e-7f, rr);
        rc[idx] = cosf(rr); rs[idx] = sinf(rr);
    }
}

DI void build_pbase(const Ctx& c, int layer, LAS int* pbase) {
    const unsigned* cnt = WSP(unsigned, WS_CTL) + CW_CNT + layer * 32;
    if (c.tid == 0) { int s = 0; for (int e = 0; e < 32; ++e) { pbase[e] = s; s += ((int)cnt[e] + 255) & ~255; } pbase[32] = s; }
    __syncthreads();
}
struct Route { int e[4], s[4]; float w[4]; };
DI void route_load(const Ctx& c, int row, Route& r) {
    const int* tok_e = WSP(int, WS_ROUTE); const int* tok_slot = tok_e + NTOK * 4; const float* tok_w = (const float*)(tok_slot + NTOK * 4);
    typedef int i4 __attribute__((ext_vector_type(4)));
    const i4 e = *(const i4*)(tok_e + row * 4), s = *(const i4*)(tok_slot + row * 4); const f32x4 w = *(const f32x4*)(tok_w + row * 4);
    r.e[0] = e.x; r.e[1] = e.y; r.e[2] = e.z; r.e[3] = e.w; r.s[0] = s.x; r.s[1] = s.y; r.s[2] = s.z; r.s[3] = s.w; r.w[0] = w.x; r.w[1] = w.y; r.w[2] = w.z; r.w[3] = w.w;
}
template <bool LAST> DI void comb_issue(const Ctx& c, const LAS int* pbase, const Route& r, int row, unsigned (&y)[4][4], u32x2 (&h)[4]) {
    const unsigned char* Y = WSP(unsigned char, WS_XP); const bf16* H = WSP(bf16, WS_H);
#pragma unroll
    for (int k = 0; k < 4; ++k) { const int prow = pbase[r.e[k]] + r.s[k];
#pragma unroll
        for (int j = 0; j < 4; ++j) { const unsigned* p = (const unsigned*)(Y + (size_t)prow * 1024 + 4 * (c.lane + 64 * j)); y[k][j] = __builtin_nontemporal_load(p); } }
#pragma unroll
    for (int j = 0; j < 4; ++j) { const u32x2* p = (const u32x2*)(H + (size_t)row * 1024 + 4 * (c.lane + 64 * j)); h[j] = LAST ? __builtin_nontemporal_load(p) : *p; }
}
DI void comb_reduce(const Ctx& c, const Route& r, const unsigned (&y)[4][4], const u32x2 (&h)[4], const float* g2, f32x4 (&v)[4]) {
#pragma unroll
    for (int j = 0; j < 4; ++j) { f32x4 s = fp8x4_to_f32(y[0][j]) * r.w[0]; s += fp8x4_to_f32(y[1][j]) * r.w[1]; s += fp8x4_to_f32(y[2][j]) * r.w[2]; s += fp8x4_to_f32(y[3][j]) * r.w[3];
        v[j] = (f32x4){bflo(h[j].x), bfhi(h[j].x), bflo(h[j].y), bfhi(h[j].y)} + *(const f32x4*)(g2 + 4 * (c.lane + 64 * j)) * s; }
}
#define COMB_PIPE_BEGIN(NROWS, LAST) \
    const int stride_ = c.G * NWAVES; int row = blockIdx.x * NWAVES + c.wave; \
    Route r0, r1, r2; unsigned yc[4][4], yn[4][4]; u32x2 hc[4], hn[4]; \
    if (row < (NROWS)) { route_load(c, row, r0); comb_issue<LAST>(c, pbase, r0, row, yc, hc); } \
    if (row + stride_ < (NROWS)) route_load(c, row + stride_, r1); \
    for (; row < (NROWS); row += stride_) { \
        if (row + stride_ < (NROWS)) comb_issue<LAST>(c, pbase, r1, row + stride_, yn, hn); \
        if (row + 2 * stride_ < (NROWS)) route_load(c, row + 2 * stride_, r2);
#define COMB_PIPE_END() \
        r0 = r1; r1 = r2; \
        _Pragma("unroll") for (int k_ = 0; k_ < 4; ++k_) { _Pragma("unroll") for (int j_ = 0; j_ < 4; ++j_) yc[k_][j_] = yn[k_][j_]; } \
        _Pragma("unroll") for (int j_ = 0; j_ < 4; ++j_) hc[j_] = hn[j_]; }
DI void norm_store_u(const Ctx& c, const float* ng, const float* m, f32x4 (&v)[4], bf16* urow) {
    float ss = 0.f;
#pragma unroll
    for (int j = 0; j < 4; ++j) ss += (v[j].x * v[j].x + v[j].y * v[j].y) + (v[j].z * v[j].z + v[j].w * v[j].w);
    const float rstd = rsqrtf(wave_sum(ss) * (1.f / 1024.f) + EPS);
#pragma unroll
    for (int j = 0; j < 4; ++j) { const int col = 4 * (c.lane + 64 * j);
        const f32x4 g = *(const f32x4*)(ng + col), sh = *(const f32x4*)(m + col), scl = *(const f32x4*)(m + 1024 + col);
        const f32x4 o = (v[j] * rstd * g) * (scl + 1.f) + sh;
        u32x2 w; w.x = pk2(o.x, o.y); w.y = pk2(o.z, o.w); *(u32x2*)(urow + col) = w; }
}
DI void phase_norm1(const Ctx& c, const Args& a, int layer) {
    const float* mod = WSP(float, WS_MOD); bf16* H = WSP(bf16, WS_H); bf16* U = WSP(bf16, WS_U);
    const float* ng = a.in[I_NORMG] + (layer * 2 + 0) * 1024;
    LAS int* pbase = (LAS int*)c.lds;
    if (layer == 0) {
        for (int row = blockIdx.x * NWAVES + c.wave; row < NTOK; row += c.G * NWAVES) {
            const int r = row < NLAT ? row >> 13 : 4;
            const float* src = row < NLAT ? a.in[I_X] + (size_t)row * 1024 : a.in[I_CTX] + (size_t)(row - NLAT) * 1024;
            f32x4 v[4];
#pragma unroll
            for (int j = 0; j < 4; ++j) v[j] = __builtin_nontemporal_load((const f32x4*)(src + 4 * (c.lane + 64 * j)));
            norm_store_u(c, ng, mod + (layer * 5 + r) * 6144, v, U + (size_t)row * 1024);
        }
    } else {
        build_pbase(c, layer - 1, pbase);
        COMB_PIPE_BEGIN(NTOK, false)
            const int r = row < NLAT ? row >> 13 : 4;
            f32x4 v[4]; comb_reduce(c, r0, yc, hc, mod + ((layer - 1) * 5 + r) * 6144 + 5 * 1024, v);
#pragma unroll
            for (int j = 0; j < 4; ++j) { u32x2 hw; hw.x = pk2(v[j].x, v[j].y); hw.y = pk2(v[j].z, v[j].w); *(u32x2*)(H + (size_t)row * 1024 + 4 * (c.lane + 64 * j)) = hw; }
            norm_store_u(c, ng, mod + (layer * 5 + r) * 6144, v, U + (size_t)row * 1024);
        COMB_PIPE_END()
    }
    __syncthreads();
}

struct EpiProj {
    static constexpr bool PERM = true, AFTER_DRAIN = false;
    bf16* P; float* Gt; const float* qkg;
    __device__ __forceinline__ void operator()(const pg8::f32x4 (&acc)[2][2][4][2], const pg8::Unit& u, int wr, int wc, int fr, int fq) const {
        const int row0 = u.pm * 256 + wr * 64 + fr;
        if (u.pn < 4) {
            const float* g = qkg + (u.pn >> 1) * 64 + 8 * fq; const float qs = u.pn < 2 ? 0.125f * LOG2E : 1.f;
            const pg8::f32x4 g0 = *(const pg8::f32x4*)g * qs, g1 = *(const pg8::f32x4*)(g + 4) * qs, g2 = *(const pg8::f32x4*)(g + 32) * qs, g3 = *(const pg8::f32x4*)(g + 36) * qs;
            const int col0 = u.pn * 256 + wc * 64 + 8 * fq;
#pragma unroll
            for (int ai = 0; ai < 2; ++ai)
#pragma unroll
                for (int m = 0; m < 4; ++m) {
                    const pg8::f32x4 a0 = acc[ai][0][m][0], a1 = acc[ai][0][m][1], b0 = acc[ai][1][m][0], b1 = acc[ai][1][m][1];
                    float ss = (a0[0] * a0[0] + a0[1] * a0[1]) + (a0[2] * a0[2] + a0[3] * a0[3]) + (a1[0] * a1[0] + a1[1] * a1[1]) + (a1[2] * a1[2] + a1[3] * a1[3])
                             + (b0[0] * b0[0] + b0[1] * b0[1]) + (b0[2] * b0[2] + b0[3] * b0[3]) + (b1[0] * b1[0] + b1[1] * b1[1]) + (b1[2] * b1[2] + b1[3] * b1[3]);
                    ss = col4_sum(ss);
                    const float rstd = __builtin_amdgcn_rsqf(ss * (1.f / 64.f) + EPS);
                    const pg8::f32x4 o0 = a0 * g0 * rstd, o1 = a1 * g1 * rstd, o2 = b0 * g2 * rstd, o3 = b1 * g3 * rstd;
                    bf16* rowp = P + (size_t)(row0 + ai * 128 + m * 16) * NPROJ + col0;
                    u32x4 w; w.x = pk2(o0[0], o0[1]); w.y = pk2(o0[2], o0[3]); w.z = pk2(o1[0], o1[1]); w.w = pk2(o1[2], o1[3]); *(u32x4*)rowp = w;
                    w.x = pk2(o2[0], o2[1]); w.y = pk2(o2[2], o2[3]); w.z = pk2(o3[0], o3[1]); w.w = pk2(o3[2], o3[3]); *(u32x4*)(rowp + 32) = w; }
        } else if (u.pn < 14) {
            const int col0 = u.pn * 256 + wc * 32 + 8 * fq;
#pragma unroll
            for (int ai = 0; ai < 2; ++ai)
#pragma unroll
                for (int m = 0; m < 4; ++m) { bf16* rowp = P + (size_t)(row0 + ai * 128 + m * 16) * NPROJ + col0;
#pragma unroll
                    for (int bj = 0; bj < 2; ++bj) { const pg8::f32x4 v0 = acc[ai][bj][m][0], v1 = acc[ai][bj][m][1];
                        u32x4 w; w.x = pk2(v0[0], v0[1]); w.y = pk2(v0[2], v0[3]); w.z = pk2(v1[0], v1[1]); w.w = pk2(v1[2], v1[3]);
                        *(u32x4*)(rowp + bj * 128) = w; } }
        } else if (wc == 0 && fq < 3) {
#pragma unroll
            for (int ai = 0; ai < 2; ++ai)
#pragma unroll
                for (int m = 0; m < 4; ++m) { float* gp = Gt + (size_t)(8 * fq) * NTOK + (row0 + ai * 128 + m * 16);
#pragma unroll
                    for (int n = 0; n < 2; ++n)
#pragma unroll
                        for (int q = 0; q < 4; ++q) gp[(size_t)(4 * n + q) * NTOK] = acc[ai][0][m][n][q]; }
        }
    }
};
struct EpiRes {
    static constexpr bool PERM = false, AFTER_DRAIN = false;
    bf16* H; const float* g1; const float* srcl; const float* srcc; int from_h;
    __device__ __forceinline__ void operator()(const pg8::f32x4 (&acc)[2][2][4][2], const pg8::Unit& u, int wr, int wc, int fr, int fq) const {
        const int row0 = u.pm * 256 + wr * 64 + fr, col0 = u.pn * 256 + wc * 32 + 4 * fq;
        const float* g = g1 + (u.pm < 128 ? (u.pm >> 5) : 4) * 6144;
        pg8::f32x4 gv[2][2];
#pragma unroll
        for (int bj = 0; bj < 2; ++bj)
#pragma unroll
            for (int n = 0; n < 2; ++n) gv[bj][n] = *(const pg8::f32x4*)(g + col0 + bj * 128 + n * 16);
        const int sel = fq & 1;
#pragma unroll
        for (int ai = 0; ai < 2; ++ai)
#pragma unroll
            for (int p = 0; p < 2; ++p) {
                unsigned wv[2][2][2][2];
#pragma unroll
                for (int mm = 0; mm < 2; ++mm) { const int rr = row0 + ai * 128 + (2 * p + mm) * 16; const bf16* rowp = H + (size_t)rr * 1024 + col0;
                    const float* sp = (u.pm < 128 ? srcl + (size_t)rr * 1024 : srcc + (size_t)(rr - NLAT) * 1024) + col0;
#pragma unroll
                    for (int bj = 0; bj < 2; ++bj)
#pragma unroll
                        for (int n = 0; n < 2; ++n) { pg8::f32x4 res;
                            if (from_h) { const u32x2 hv = *(const u32x2*)(rowp + bj * 128 + n * 16); res = (pg8::f32x4){bflo(hv.x), bfhi(hv.x), bflo(hv.y), bfhi(hv.y)}; }
                            else res = *(const pg8::f32x4*)(sp + bj * 128 + n * 16);
                            const pg8::f32x4 o = res + gv[bj][n] * acc[ai][bj][2 * p + mm][n];
                            wv[mm][bj][n][0] = pk2(o[0], o[1]); wv[mm][bj][n][1] = pk2(o[2], o[3]); } }
                bf16* outp = H + (size_t)(row0 + ai * 128 + (2 * p + sel) * 16) * 1024 + (col0 - 4 * sel);
#pragma unroll
                for (int bj = 0; bj < 2; ++bj)
#pragma unroll
                    for (int n = 0; n < 2; ++n) {
                        swap16u(wv[0][bj][n][0], wv[1][bj][n][0]); swap16u(wv[0][bj][n][1], wv[1][bj][n][1]);
                        u32x4 w; w.x = wv[0][bj][n][0]; w.y = wv[0][bj][n][1]; w.z = wv[1][bj][n][0]; w.w = wv[1][bj][n][1];
                        *(u32x4*)(outp + bj * 128 + n * 16) = w; } }
    }
};
struct EpiSwiglu {
    static constexpr bool PERM = true, AFTER_DRAIN = false;
    unsigned char* A2; const float* b1;
    __device__ __forceinline__ void operator()(const pg8::f32x4 (&acc)[2][2][4][2], const pg8::Unit& u, int wr, int wc, int fr, int fq) const {
        const int e = u.pn >> 3, pn = u.pn & 7, row0 = u.pm * 256 + wr * 64 + fr, j0 = pn * 128 + wc * 32 + 8 * fq;
        const float* bg = b1 + e * 2048 + j0; const float* bl = bg + 1024;
        typedef float f2v __attribute__((ext_vector_type(2)));
        const pg8::f32x4 bg0 = *(const pg8::f32x4*)bg, bg1 = *(const pg8::f32x4*)(bg + 4), bl0 = *(const pg8::f32x4*)bl + 1.f, bl1 = *(const pg8::f32x4*)(bl + 4) + 1.f;
        const f2v sc = {W8_INV, W8_INV}, ne = {-1.702f * LOG2E, -1.702f * LOG2E}, one = {1.f, 1.f};
        const int sel = fq & 1; unsigned char* base = A2 + (size_t)(row0 + sel * 16) * 1024 + (j0 - 8 * sel);
#pragma unroll
        for (int ai = 0; ai < 2; ++ai)
#pragma unroll
            for (int p = 0; p < 2; ++p) {
                unsigned wv[2][2];
#pragma unroll
                for (int mm = 0; mm < 2; ++mm) { const int m = 2 * p + mm;
                    f2v o[4];
#pragma unroll
                    for (int n = 0; n < 2; ++n) {
                        const pg8::f32x4 ag = acc[ai][0][m][n], al = acc[ai][1][m][n], vbg = n ? bg1 : bg0, vbl = n ? bl1 : bl0;
#pragma unroll
                        for (int h = 0; h < 2; ++h) {
                            f2v g = (h ? __builtin_shufflevector(ag, ag, 2, 3) : __builtin_shufflevector(ag, ag, 0, 1)) * sc + (h ? __builtin_shufflevector(vbg, vbg, 2, 3) : __builtin_shufflevector(vbg, vbg, 0, 1));
                            f2v l = (h ? __builtin_shufflevector(al, al, 2, 3) : __builtin_shufflevector(al, al, 0, 1)) * sc + (h ? __builtin_shufflevector(vbl, vbl, 2, 3) : __builtin_shufflevector(vbl, vbl, 0, 1));
                            g.x = fminf(g.x, 7.f); g.y = fminf(g.y, 7.f);
                            l.x = __builtin_amdgcn_fmed3f(l.x, -6.f, 8.f); l.y = __builtin_amdgcn_fmed3f(l.y, -6.f, 8.f);
                            const f2v t = g * ne; f2v d = {__builtin_amdgcn_exp2f(t.x), __builtin_amdgcn_exp2f(t.y)}; d = d + one;
                            const f2v r = {__builtin_amdgcn_rcpf(d.x), __builtin_amdgcn_rcpf(d.y)};
                            o[n * 2 + h] = (g * l) * r; } }
                    wv[mm][0] = pk4_fp8(o[0].x, o[0].y, o[1].x, o[1].y); wv[mm][1] = pk4_fp8(o[2].x, o[2].y, o[3].x, o[3].y); }
                swap16u(wv[0][0], wv[1][0]); swap16u(wv[0][1], wv[1][1]);
                u32x4 w; w.x = wv[0][0]; w.y = wv[0][1]; w.z = wv[1][0]; w.w = wv[1][1];
                *(u32x4*)(base + (size_t)(ai * 128 + p * 32) * 1024) = w; }
    }
};
struct EpiMoeOut {
    static constexpr bool PERM = true, AFTER_DRAIN = false;
    unsigned char* Y; const float* b2;
    __device__ __forceinline__ void operator()(const pg8::f32x4 (&acc)[2][2][4][2], const pg8::Unit& u, int wr, int wc, int fr, int fq) const {
        const int e = u.pn >> 2, pn = u.pn & 3, row0 = u.pm * 256 + wr * 64 + fr, col0 = pn * 256 + wc * 32 + 8 * fq;
        pg8::f32x4 bv[2][2];
#pragma unroll
        for (int bj = 0; bj < 2; ++bj)
#pragma unroll
            for (int n = 0; n < 2; ++n) bv[bj][n] = *(const pg8::f32x4*)(b2 + e * 1024 + col0 + bj * 128 + 4 * n);
        const int sel = fq & 1; unsigned char* base = Y + (size_t)(row0 + sel * 16) * 1024 + (col0 - 8 * sel);
#pragma unroll
        for (int ai = 0; ai < 2; ++ai)
#pragma unroll
            for (int p = 0; p < 2; ++p)
#pragma unroll
                for (int bj = 0; bj < 2; ++bj) {
                    const pg8::f32x4 a0 = acc[ai][bj][2 * p][0] * W8_INV + bv[bj][0], a1 = acc[ai][bj][2 * p][1] * W8_INV + bv[bj][1];
                    const pg8::f32x4 c0 = acc[ai][bj][2 * p + 1][0] * W8_INV + bv[bj][0], c1 = acc[ai][bj][2 * p + 1][1] * W8_INV + bv[bj][1];
                    unsigned x0 = pk4_fp8(a0[0], a0[1], a0[2], a0[3]), x1 = pk4_fp8(a1[0], a1[1], a1[2], a1[3]), y0 = pk4_fp8(c0[0], c0[1], c0[2], c0[3]), y1 = pk4_fp8(c1[0], c1[1], c1[2], c1[3]);
                    swap16u(x0, y0); swap16u(x1, y1);
                    u32x4 w; w.x = x0; w.y = x1; w.z = y0; w.w = y1;
                    *(u32x4*)(base + (size_t)(ai * 128 + p * 32) * 1024 + bj * 128) = w; }
    }
};
constexpr int ECAP = NTOK;
struct OneUnit {
    int pm, pn;
    __device__ __forceinline__ bool next(int i, pg8::Unit& u) const { if (i) return false; u.pm = pm; u.pn = pn; return true; }
    __device__ __forceinline__ void a_ready(const pg8::Unit&) const {}
    __device__ __forceinline__ void done(const pg8::Unit&) const {}
    __device__ __forceinline__ int arow(const pg8::Unit& u, int r) const { return u.pm * 256 + r; }
};
struct MoeOrder {
    const LAS int* tile_e; int ntiles, ntshift, G, cc; const int* etok; const unsigned* cnt;
    __device__ __forceinline__ bool next(int i, pg8::Unit& u) const {
        const int L = i * G + cc; if (L >= (ntiles << ntshift)) return false;
        const int pm = L >> ntshift; u.pm = pm; u.pn = (__builtin_amdgcn_readfirstlane(tile_e[pm]) << ntshift) + (L & ((1 << ntshift) - 1)); return true; }
    __device__ __forceinline__ void a_ready(const pg8::Unit&) const {}
    __device__ __forceinline__ void done(const pg8::Unit&) const {}
    __device__ __forceinline__ int arow(const pg8::Unit& u, int r) const {
        const int e = u.pn >> ntshift, slot = tile_e[MAXTILES + u.pm] + r; return slot < (int)cnt[e] ? etok[(size_t)e * ECAP + slot] : 0; }
};
#define XB_TMO      128
#define XB_XCNT(j)  (256  + 64 * (j))
#define XB_XSUB(j)  (1280 + 64 * (j))
#define XB_XGEN(j)  (2304 + 64 * (j))
#define XB_TOP      3328
#define XB_TOPGEN   3392
#define XCD_BAR_WORDS 3456
#define XB_SPIN_CAP (1u << 18)

__device__ __forceinline__ unsigned xb_ld(unsigned* p)              { return __hip_atomic_load(p, __ATOMIC_RELAXED, __HIP_MEMORY_SCOPE_AGENT); }
__device__ __forceinline__ unsigned xb_add(unsigned* p, unsigned v) { return __hip_atomic_fetch_add(p, v, __ATOMIC_RELAXED, __HIP_MEMORY_SCOPE_AGENT); }
__device__ __forceinline__ unsigned xb_xcc_id() { return (unsigned)__builtin_amdgcn_s_getreg((3 << 11) | 20) & 0xFu; }
#define XB_SPIN(cond, bar) do { unsigned _sp = 0; while (cond) { __builtin_amdgcn_s_sleep(1); \
    if ((++_sp & 255u) == 0u) { if (xb_ld(&(bar)[XB_TMO])) break; if (_sp > XB_SPIN_CAP) { atomicAdd(&(bar)[XB_TMO], 1u); break; } } } } while (0)

struct XcdBarrier {
    unsigned* bar; unsigned x;
    volatile LAS unsigned* st;
};

__device__ __forceinline__ XcdBarrier xcd_barrier_post(unsigned* bar, volatile LAS unsigned* st) {
    XcdBarrier b; b.bar = bar; b.x = xb_xcc_id(); b.st = st;
    if (threadIdx.x == 0) (void)xb_add(&bar[XB_XCNT(b.x)], 1u);
    return b;
}
__device__ __forceinline__ void xcd_barrier_complete(unsigned* bar, unsigned x, unsigned& nloc, unsigned& nx) {
    const unsigned G = gridDim.x * gridDim.y * gridDim.z;
    unsigned sum, cnt, mine, sp = 0u;
    for (;;) {
        sum = 0u; cnt = 0u; mine = 0u;
#pragma unroll
        for (unsigned j = 0; j < 16; ++j) { const unsigned c = xb_ld(&bar[XB_XCNT(j)]); sum += c; cnt += (c > 0u) ? 1u : 0u; mine = (j == x) ? c : mine; }
        if (sum == G) break;
        __builtin_amdgcn_s_sleep(1);
        if ((++sp & 255u) == 0u) { if (xb_ld(&bar[XB_TMO])) break; if (sp > XB_SPIN_CAP) { atomicAdd(&bar[XB_TMO], 1u); break; } }
    }
    nloc = mine > 0u ? mine : 1u; nx = cnt > 0u ? cnt : 1u;
}

__device__ __forceinline__ void xcd_barrier(const XcdBarrier& b) {
    asm volatile("s_waitcnt vmcnt(0)" ::: "memory");
    __syncthreads();
    if (threadIdx.x == 0) {
        unsigned* bar = b.bar;
        __builtin_amdgcn_s_waitcnt(0);
        unsigned nloc = b.st[0], nx = b.st[1];
        if (nloc == 0u) { xcd_barrier_complete(bar, b.x, nloc, nx); b.st[0] = nloc; b.st[1] = nx; }
        const unsigned old = xb_add(&bar[XB_XSUB(b.x)], 1u);
        const unsigned gen = old / nloc;
        if (old + 1u == (gen + 1u) * nloc) {
            __builtin_amdgcn_fence(__ATOMIC_RELEASE, "agent");
            asm volatile("s_waitcnt vmcnt(0)" ::: "memory");
            const unsigned og = xb_add(&bar[XB_TOP], 1u);
            const unsigned tg = og / nx;
            if (og + 1u == (tg + 1u) * nx) xb_add(&bar[XB_TOPGEN], 1u);
            else XB_SPIN(xb_ld(&bar[XB_TOPGEN]) == tg, bar);
            __builtin_amdgcn_fence(__ATOMIC_ACQUIRE, "agent");
            xb_add(&bar[XB_XGEN(b.x)], 1u);
            asm volatile("s_waitcnt vmcnt(0)" ::: "memory");
        } else {
            XB_SPIN(xb_ld(&bar[XB_XGEN(b.x)]) == gen, bar);
            __builtin_amdgcn_fence(__ATOMIC_ACQUIRE, "agent");
            asm volatile("s_waitcnt vmcnt(0)" ::: "memory");
        }
    }
    __syncthreads();
}


DI void chunk_info(int b, int sc, int& seqbase, int& t0, int& slen) {
    if (sc < 2) { seqbase = NLAT + b * CTXL; t0 = sc * 128; slen = CTXL; } else { seqbase = b * SEQ; t0 = (sc - 2) * 128; slen = SEQ; }
}
constexpr int LD = 136;
constexpr int TILE_B = 128 * LD * 2;

template <int NT> DI void conv_wt_load(const Ctx& c, const float* cw, const float* cb, const int (&ch0)[NT], LAS float* wt) {
    if (c.tid < 192) { const int k = c.tid >> 5, j = c.tid & 31; const float* src = (k < 5 ? cw + k * 768 : cb) + 4 * j;
#pragma unroll
        for (int t = 0; t < NT; ++t) *(LAS f32x4*)(wt + t * 768 + k * 128 + 4 * j) = *(const f32x4*)(src + ch0[t]); }
}
DI void conv_load(const Ctx& c, const bf16* proj, const LAS float* wt, int seqbase, int t0, int slen, int ch0, LAS bf16* dst) {
    const int cg = c.tid & 15, tg = c.tid >> 4, ch = ch0 + 8 * cg, tb = t0 + 4 * tg - 2;
    u32x4 raw[8];
#pragma unroll
    for (int q = 0; q < 8; ++q) { const int tt = tb + q; raw[q] = (u32x4){0u, 0u, 0u, 0u};
        if (tt >= 0 && tt < slen) raw[q] = *(const u32x4*)(proj + (size_t)(seqbase + tt) * NPROJ + C_XBC + ch); }
    f32x4 w0[5], w1[5];
#pragma unroll
    for (int k = 0; k < 5; ++k) { w0[k] = *(const LAS f32x4*)(wt + k * 128 + 8 * cg); w1[k] = *(const LAS f32x4*)(wt + k * 128 + 8 * cg + 4); }
    const f32x4 b0 = *(const LAS f32x4*)(wt + 640 + 8 * cg), b1 = *(const LAS f32x4*)(wt + 640 + 8 * cg + 4);
#pragma unroll
    for (int o = 0; o < 4; ++o) {
        f32x4 a0 = b0, a1 = b1;
#pragma unroll
        for (int k = 0; k < 5; ++k) { const u32x4 r = raw[o + k];
            a0.x += bflo(r.x) * w0[k].x; a0.y += bfhi(r.x) * w0[k].y; a0.z += bflo(r.y) * w0[k].z; a0.w += bfhi(r.y) * w0[k].w;
            a1.x += bflo(r.z) * w1[k].x; a1.y += bfhi(r.z) * w1[k].y; a1.z += bflo(r.w) * w1[k].z; a1.w += bfhi(r.w) * w1[k].w; }
        u32x4 ov; ov.x = pk2(siluf(a0.x), siluf(a0.y)); ov.y = pk2(siluf(a0.z), siluf(a0.w)); ov.z = pk2(siluf(a1.x), siluf(a1.y)); ov.w = pk2(siluf(a1.z), siluf(a1.w));
        *(LAS u32x4*)(dst + (4 * tg + o) * LD + 8 * cg) = ov; }
}
DI void ml_load_qk(const Ctx& c, const bf16* proj, const float* rc, const float* rs, int rowbase, int t0, bool lat, int colbase, int hp, LAS bf16* dst) {
#pragma unroll
    for (int i = 0; i < 2; ++i) {
        const int idx = c.tid + NTHR * i, cq = idx & 3, hh = (idx >> 2) & 1, t = idx >> 3;
        const bf16* src = proj + (size_t)(rowbase + t) * NPROJ + colbase + (2 * hp + hh) * 64;
        u32x4 r1 = *(const u32x4*)(src + 8 * cq), r2 = *(const u32x4*)(src + 32 + 8 * cq);
        if (lat) {
            const float* cs = rc + (size_t)(t0 + t) * 32 + 8 * cq; const float* sn = rs + (size_t)(t0 + t) * 32 + 8 * cq;
            const f32x4 c0 = *(const f32x4*)cs, c1 = *(const f32x4*)(cs + 4), s0 = *(const f32x4*)sn, s1 = *(const f32x4*)(sn + 4);
            u32x4 o1, o2;
#define ROT(W, CA, SA, CB, SB) { const float x1a = bflo(r1.W), x1b = bfhi(r1.W), x2a = bflo(r2.W), x2b = bfhi(r2.W); \
            o1.W = pk2(x1a * CA - x2a * SA, x1b * CB - x2b * SB); o2.W = pk2(x1a * SA + x2a * CA, x1b * SB + x2b * CB); }
            ROT(x, c0.x, s0.x, c0.y, s0.y) ROT(y, c0.z, s0.z, c0.w, s0.w) ROT(z, c1.x, s1.x, c1.y, s1.y) ROT(w, c1.z, s1.z, c1.w, s1.w)
#undef ROT
            r1 = o1; r2 = o2; }
        *(LAS u32x4*)(dst + t * LD + hh * 64 + 8 * cq) = r1; *(LAS u32x4*)(dst + t * LD + hh * 64 + 32 + 8 * cq) = r2; }
}
DI void ml_load_qk2(const Ctx& c, const bf16* proj, const float* rc, const float* rs, int rowbase, int t0, bool lat, int hp, LAS bf16* dq, LAS bf16* dk) {
#pragma unroll
    for (int i = 0; i < 2; ++i) {
        const int idx = c.tid + NTHR * i, cq = idx & 3, hh = (idx >> 2) & 1, t = idx >> 3;
        const bf16* sq = proj + (size_t)(rowbase + t) * NPROJ + C_MLQ + (2 * hp + hh) * 64; const bf16* sk = sq + (C_MLK - C_MLQ);
        u32x4 r1 = *(const u32x4*)(sq + 8 * cq), r2 = *(const u32x4*)(sq + 32 + 8 * cq), k1 = *(const u32x4*)(sk + 8 * cq), k2 = *(const u32x4*)(sk + 32 + 8 * cq);
        if (lat) {
            const float* cs = rc + (size_t)(t0 + t) * 32 + 8 * cq; const float* sn = rs + (size_t)(t0 + t) * 32 + 8 * cq;
            const f32x4 c0 = *(const f32x4*)cs, c1 = *(const f32x4*)(cs + 4), s0 = *(const f32x4*)sn, s1 = *(const f32x4*)(sn + 4);
            u32x4 o1, o2, p1, p2;
#define ROT(A1, A2, O1, O2, W, CA, SA, CB, SB) { const float x1a = bflo(A1.W), x1b = bfhi(A1.W), x2a = bflo(A2.W), x2b = bfhi(A2.W); \
            O1.W = pk2(x1a * CA - x2a * SA, x1b * CB - x2b * SB); O2.W = pk2(x1a * SA + x2a * CA, x1b * SB + x2b * CB); }
            ROT(r1, r2, o1, o2, x, c0.x, s0.x, c0.y, s0.y) ROT(r1, r2, o1, o2, y, c0.z, s0.z, c0.w, s0.w) ROT(r1, r2, o1, o2, z, c1.x, s1.x, c1.y, s1.y) ROT(r1, r2, o1, o2, w, c1.z, s1.z, c1.w, s1.w)
            ROT(k1, k2, p1, p2, x, c0.x, s0.x, c0.y, s0.y) ROT(k1, k2, p1, p2, y, c0.z, s0.z, c0.w, s0.w) ROT(k1, k2, p1, p2, z, c1.x, s1.x, c1.y, s1.y) ROT(k1, k2, p1, p2, w, c1.z, s1.z, c1.w, s1.w)
#undef ROT
            r1 = o1; r2 = o2; k1 = p1; k2 = p2; }
        *(LAS u32x4*)(dq + t * LD + hh * 64 + 8 * cq) = r1; *(LAS u32x4*)(dq + t * LD + hh * 64 + 32 + 8 * cq) = r2;
        *(LAS u32x4*)(dk + t * LD + hh * 64 + 8 * cq) = k1; *(LAS u32x4*)(dk + t * LD + hh * 64 + 32 + 8 * cq) = k2; }
}
DI void ml_load_v(const Ctx& c, const bf16* proj, int rowbase, int colbase, int hp, LAS bf16* dst) {
#pragma unroll
    for (int i = 0; i < 4; ++i) { const int idx = c.tid + NTHR * i, cc = idx & 15, t = idx >> 4;
        *(LAS u32x4*)(dst + t * LD + 8 * cc) = *(const u32x4*)(proj + (size_t)(rowbase + t) * NPROJ + colbase + 2 * hp * 64 + 8 * cc); }
}

DI void ssd_states_task(const Ctx& c0, const Args& a, int layer, int b, int sc, int g) {
    Ctx c = c0; fresh_ctx(c);
    LAS bf16* Xs = (LAS bf16*)c.lds; LAS bf16* Bs = Xs + 128 * LD; LAS float* wts = (LAS float*)(c.lds + 2 * TILE_B);
    const bf16* proj = WSP(bf16, WS_PROJ); const float* gates = WSP(float, WS_GATES);
    int seqbase, t0, slen; chunk_info(b, sc, seqbase, t0, slen); const int rowbase = seqbase + t0;
    const float* cw = a.in[I_CONVW] + layer * 5 * 768; const float* cb = a.in[I_CONVB] + layer * 768;
    LAS float* wtab = (LAS float*)(c.lds + 3 * TILE_B);
    { const int chs[2] = {128 * g, 256 + 128 * g}; conv_wt_load<2>(c, cw, cb, chs, wtab); }
    __syncthreads();
    conv_load(c, proj, wtab, seqbase, t0, slen, 128 * g, Xs);
    conv_load(c, proj, wtab + 768, seqbase, t0, slen, 256 + 128 * g, Bs);
    if (c.wave < 4) {
        const int combo = c.wave, dir = combo >> 1, h = 2 * g + (combo & 1), dh = dir * 4 + h;
        const float ac = -__expf(a.in[I_ALOG][layer * 8 + dh]), dtb = a.in[I_DTB][layer * 8 + dh];
        const int ta = dir ? 127 - 2 * c.lane : 2 * c.lane, tb = dir ? 126 - 2 * c.lane : 2 * c.lane + 1;
        const float dta = softplusf(gates[(size_t)dh * NTOK + rowbase + ta] + dtb), dtb2 = softplusf(gates[(size_t)dh * NTOK + rowbase + tb] + dtb);
        const float la = dta * ac, lb = dtb2 * ac, s = la + lb, incl = scan_add(s, c.lane), excl = incl - s, total = rl_f(incl, 63);
        wts[combo * 128 + ta] = __expf(total - (excl + la)) * dta; wts[combo * 128 + tb] = __expf(total - incl) * dtb2;
        if (c.lane == 0) WSP(float, WS_MISC)[4 * NSIDX + ((b * 2 + dir) * 4 + h) * NSC + sc] = __expf(total);
    }
    __syncthreads();
    {
        const int combo = c.wave >> 1, half = c.wave & 1, dir = combo >> 1, hh = combo & 1, h = 2 * g + hh, gq = c.lane >> 4;
        bf16* S = WSP(bf16, WS_SSTB) + (size_t)(((b * 2 + dir) * 4 + h) * NSC + sc) * 8192;
        bf16x8 xw[4][4];
#pragma unroll
        for (int ks = 0; ks < 4; ++ks) { const LAS float* wp = wts + combo * 128 + 32 * ks + 8 * gq; const f32x4 w0 = *(const LAS f32x4*)wp, w1 = *(const LAS f32x4*)(wp + 4);
#pragma unroll
            for (int pb = 0; pb < 4; ++pb) xw[ks][pb] = scale_frag(frag_tr(Xs, LD, 32 * ks, 64 * hh + 16 * pb, c.lane), w0, w1); }
#pragma unroll
        for (int nb = 0; nb < 4; ++nb) { const int n0 = 16 * (4 * half + nb);
            f32x4 acc[4];
#pragma unroll
            for (int pb = 0; pb < 4; ++pb) acc[pb] = (f32x4){0.f, 0.f, 0.f, 0.f};
#pragma unroll
            for (int ks = 0; ks < 4; ++ks) { const bf16x8 af = frag_tr(Bs, LD, 32 * ks, n0, c.lane);
#pragma unroll
                for (int pb = 0; pb < 4; ++pb) acc[pb] = mfma16(af, xw[ks][pb], acc[pb]); }
#pragma unroll
            for (int q = 0; q < 2; ++q) { u32x2 wa, wb; wa.x = pk2(acc[2 * q].x, acc[2 * q].y); wa.y = pk2(acc[2 * q].z, acc[2 * q].w); wb.x = pk2(acc[2 * q + 1].x, acc[2 * q + 1].y); wb.y = pk2(acc[2 * q + 1].z, acc[2 * q + 1].w);
                const int sel = gq & 1; *(u32x4*)(S + (16 * (2 * q + sel) + (c.lane & 15)) * 128 + n0 + 4 * (gq - sel)) = widen16(wa, wb); } }
    }
    __syncthreads();
}
DI void ml_states_task(const Ctx& c0, const Args& a, int layer, int b, int sc, int hp) {
    Ctx c = c0; fresh_ctx(c);
    LAS bf16* Ks = (LAS bf16*)c.lds; LAS bf16* Vs = Ks + 128 * LD; LAS float* ew = (LAS float*)(c.lds + 2 * TILE_B);
    const bf16* proj = WSP(bf16, WS_PROJ); const float* gates = WSP(float, WS_GATES); float* misc = WSP(float, WS_MISC);
    int seqbase, t0, slen; chunk_info(b, sc, seqbase, t0, slen); const int rowbase = seqbase + t0;
    ml_load_qk(c, proj, WSP(float, WS_ROPE), WSP(float, WS_ROPE) + 8192 * 32, rowbase, t0, sc >= 2, C_MLK, hp, Ks);
    ml_load_v(c, proj, rowbase, C_MLV, hp, Vs);
    if (c.wave < 4) {
        const int combo = c.wave, dir = combo >> 1, h = 2 * hp + (combo & 1), dh = dir * 4 + h;
        const float bi = a.in[I_MLGB][layer * 16 + dir * 8 + h], bfg = a.in[I_MLGB][layer * 16 + dir * 8 + 4 + h];
        const int ta = dir ? 127 - 2 * c.lane : 2 * c.lane, tb = dir ? 126 - 2 * c.lane : 2 * c.lane + 1;
        const float* ga = gates + rowbase + ta; const float* gb = gates + rowbase + tb;
        const float lia = ga[(size_t)(8 + dh) * NTOK] + bi, lib = gb[(size_t)(8 + dh) * NTOK] + bi, lfa = logsigf(ga[(size_t)(16 + dh) * NTOK] + bfg), lfb = logsigf(gb[(size_t)(16 + dh) * NTOK] + bfg);
        const float s = lfa + lfb, incl = scan_add(s, c.lane), excl = incl - s, total = rl_f(incl, 63);
        const float aa = lia - (excl + lfa), ab = lib - incl, amax = wave_max(fmaxf(aa, ab));
        ew[combo * 128 + ta] = __expf(aa - amax); ew[combo * 128 + tb] = __expf(ab - amax);
        if (c.lane == 0) { const int sidx = ((b * 2 + dir) * 4 + h) * NSC + sc; misc[1 * NSIDX + sidx] = total; misc[0 * NSIDX + sidx] = total + amax; }
    }
    __syncthreads();
    {
        const int combo = c.wave >> 1, half = c.wave & 1, dir = combo >> 1, hh = combo & 1, h = 2 * hp + hh, gq = c.lane >> 4;
        bf16* Cst = WSP(bf16, WS_MCB) + (size_t)(((b * 2 + dir) * 4 + h) * NSC + sc) * 4096;
        bf16x8 vw[4][4];
#pragma unroll
        for (int ks = 0; ks < 4; ++ks) { const LAS float* wp = ew + combo * 128 + 32 * ks + 8 * gq; const f32x4 w0 = *(const LAS f32x4*)wp, w1 = *(const LAS f32x4*)(wp + 4);
#pragma unroll
            for (int eb = 0; eb < 4; ++eb) vw[ks][eb] = scale_frag(frag_tr(Vs, LD, 32 * ks, 64 * hh + 16 * eb, c.lane), w0, w1); }
#pragma unroll
        for (int db = 0; db < 2; ++db) { const int d0 = 16 * (2 * half + db);
            f32x4 acc[4];
#pragma unroll
            for (int eb = 0; eb < 4; ++eb) acc[eb] = (f32x4){0.f, 0.f, 0.f, 0.f};
#pragma unroll
            for (int ks = 0; ks < 4; ++ks) { const bf16x8 af = frag_tr(Ks, LD, 32 * ks, 64 * hh + d0, c.lane);
#pragma unroll
                for (int eb = 0; eb < 4; ++eb) acc[eb] = mfma16(af, vw[ks][eb], acc[eb]); }
#pragma unroll
            for (int q = 0; q < 2; ++q) { u32x2 wa, wb; wa.x = pk2(acc[2 * q].x, acc[2 * q].y); wa.y = pk2(acc[2 * q].z, acc[2 * q].w); wb.x = pk2(acc[2 * q + 1].x, acc[2 * q + 1].y); wb.y = pk2(acc[2 * q + 1].z, acc[2 * q + 1].w);
                const int sel = gq & 1; *(u32x4*)(Cst + (16 * (2 * q + sel) + (c.lane & 15)) * 64 + d0 + 4 * (gq - sel)) = widen16(wa, wb); } }
    }
    {
        const int combo = c.tid >> 7, d = (c.tid >> 1) & 63, hf = c.tid & 1, dir = combo >> 1, hh = combo & 1, h = 2 * hp + hh;
        float s = 0.f;
#pragma unroll 8
        for (int t = 64 * hf; t < 64 * hf + 64; ++t) s += ew[combo * 128 + t] * bf2f(Ks[t * LD + hh * 64 + d]);
        s += __shfl_xor(s, 1);
        if (!hf) WSP(float, WS_MISC)[8 * NSIDX + (size_t)(((b * 2 + dir) * 4 + h) * NSC + sc) * 64 + d] = s;
    }
    __syncthreads();
}
DI int q_pop_issue(const Ctx& c, unsigned* q); DI void q_publish(const Ctx& c, int v, int slot); DI int q_read(const Ctx& c, int slot);
DI void phase_local(const Ctx& c, const Args& a, int layer, int qid) {
    unsigned* q = WSP(unsigned, WS_CTL) + 196608 + 64 * qid;
    int cur = blockIdx.x, nxt;
    { const int v = q_pop_issue(c, q); q_publish(c, v, 0); __syncthreads(); nxt = q_read(c, 0); __syncthreads(); }
    while (cur < 1056) {
        const int nn = q_pop_issue(c, q);
        if (cur < 528) { const int b = cur / 132, rem = cur % 132; ssd_states_task(c, a, layer, b, rem >> 1, rem & 1); }
        else { const int u = cur - 528, b = u / 132, rem = u % 132; ml_states_task(c, a, layer, b, rem >> 1, rem & 1); }
        q_publish(c, nn, 0); __syncthreads(); cur = nxt; nxt = q_read(c, 0); __syncthreads();
    }
}

DI int scan_sc(int dir, int step) { return dir == 0 ? step : (step < 2 ? 1 - step : 67 - step); }
DI void ld8(const bf16* p, f32x4& a, f32x4& b) { const u32x4 r = *(const u32x4*)p; a = (f32x4){bflo(r.x), bfhi(r.x), bflo(r.y), bfhi(r.y)}; b = (f32x4){bflo(r.z), bfhi(r.z), bflo(r.w), bfhi(r.w)}; }
DI void st8(bf16* p, f32x4 a, f32x4 b) { u32x4 w; w.x = pk2(a.x, a.y); w.y = pk2(a.z, a.w); w.z = pk2(b.x, b.y); w.w = pk2(b.z, b.w); *(u32x4*)p = w; }
DI void phase_scan(const Ctx& c) {
    float* misc = WSP(float, WS_MISC);
    constexpr int N_SSD = 32 * 1024, N_MLC = 32 * 512, N_MLN = 32 * 16, NBATCH = 6, BSZ = 11;
    static_assert(NBATCH * BSZ == NSC, "scan batches");
    for (int item = (blockIdx.x + c.G * c.wave) * 64 + c.lane; item < N_SSD + N_MLC + N_MLN; item += c.G * NWAVES * 64) {
        const bool is_ssd = item < N_SSD; const int it = item - N_SSD; const bool isc = it < N_MLC;
        const int chain = is_ssd ? item >> 10 : (isc ? it >> 9 : (it - N_MLC) >> 4), dir = (chain >> 2) & 1;
        char* base; size_t stride;
        if (is_ssd) { base = (char*)(WSP(bf16, WS_SSTB) + (size_t)chain * NSC * 8192 + 8 * (item & 1023)); stride = 8192 * 2; }
        else if (isc) { base = (char*)(WSP(bf16, WS_MCB) + (size_t)chain * NSC * 4096 + 8 * (it & 511)); stride = 4096 * 2; }
        else { base = (char*)(misc + 8 * NSIDX + (size_t)chain * NSC * 64 + 4 * ((it - N_MLC) & 15)); stride = 64 * 4; }
        const float* dec = misc + 4 * NSIDX + chain * NSC; const float* mm = misc + chain * NSC; const float* mg = misc + NSIDX + chain * NSC; float* mmin = misc + 2 * NSIDX + chain * NSC;
        const bool wr_m = !is_ssd && !isc && ((it - N_MLC) & 15) == 0;
        f32x4 s0 = {0.f, 0.f, 0.f, 0.f}, s1 = s0; float m = 0.f;
        u32x4 cur[BSZ], nxt[BSZ];
#pragma unroll
        for (int j = 0; j < BSZ; ++j) cur[j] = *(const u32x4*)(base + (size_t)scan_sc(dir, j) * stride);
#pragma unroll 1
        for (int bt = 0; bt < NBATCH; ++bt) {
            if (bt + 1 < NBATCH) {
#pragma unroll
                for (int j = 0; j < BSZ; ++j) nxt[j] = *(const u32x4*)(base + (size_t)scan_sc(dir, (bt + 1) * BSZ + j) * stride); }
#pragma unroll
            for (int j = 0; j < BSZ; ++j) {
                const int sc = scan_sc(dir, bt * BSZ + j); const u32x4 r = cur[j]; u32x4* p = (u32x4*)(base + (size_t)sc * stride);
                if (is_ssd || isc) {
                    const f32x4 c0 = {bflo(r.x), bfhi(r.x), bflo(r.y), bfhi(r.y)}, c1 = {bflo(r.z), bfhi(r.z), bflo(r.w), bfhi(r.w)};
                    u32x4 w; w.x = pk2(s0.x, s0.y); w.y = pk2(s0.z, s0.w); w.z = pk2(s1.x, s1.y); w.w = pk2(s1.z, s1.w); *p = w;
                    if (is_ssd) { const float d = dec[sc]; s0 = s0 * d + c0; s1 = s1 * d + c1; }
                    else { const float ml = mm[sc], gc = mg[sc], mn = fmaxf(gc + m, ml), ao = __expf(gc + m - mn), an = __expf(ml - mn); s0 = s0 * ao + c0 * an; s1 = s1 * ao + c1 * an; m = mn; }
                } else {
                    const f32x4 c0 = __builtin_bit_cast(f32x4, r); *p = __builtin_bit_cast(u32x4, s0); if (wr_m) mmin[sc] = m;
                    const float ml = mm[sc], gc = mg[sc], mn = fmaxf(gc + m, ml), ao = __expf(gc + m - mn), an = __expf(ml - mn); s0 = s0 * ao + c0 * an; m = mn;
                }
            }
#pragma unroll
            for (int j = 0; j < BSZ; ++j) cur[j] = nxt[j];
        }
    }
}

DI void ssd_out_task(const Ctx& c0, const Args& a, int layer, int b, int sc) {
    Ctx c = c0; fresh_ctx(c);
    LAS bf16* Xs = (LAS bf16*)c.lds; LAS bf16* Bs = Xs + 128 * LD; LAS bf16* Cs = Bs + 128 * LD;
    LAS float* acum = (LAS float*)(c.lds + 3 * TILE_B); LAS float* dtv = acum + 512;
    const bf16* proj = WSP(bf16, WS_PROJ); const float* gates = WSP(float, WS_GATES);
    int seqbase, t0, slen; chunk_info(b, sc, seqbase, t0, slen); const int rowbase = seqbase + t0;
    const float* cw = a.in[I_CONVW] + layer * 5 * 768; const float* cb = a.in[I_CONVB] + layer * 768;
    const int ci = c.lane & 15, gq = c.lane >> 4, irow = 16 * c.wave + ci;
    const size_t row = (size_t)rowbase + irow; bf16* mix = WSP(bf16, WS_MIX);
    float ssq = 0.f;
    LAS float* gtab = (LAS float*)(c.lds + 3 * TILE_B + 4096 + 2 * 64 * LD * 2);
    if (c.tid < 64) *(LAS f32x4*)(gtab + 4 * c.tid) = *(const f32x4*)(a.in[I_SSMG] + layer * 256 + 4 * c.tid);
#pragma unroll 1
    for (int g = 0; g < 2; ++g) {
        fresh_ctx(c);
        const int ci = c.lane & 15, gq = c.lane >> 4, irow = 16 * c.wave + ci; const size_t row = (size_t)rowbase + irow;
        if (g) __syncthreads();
        LAS bf16* St = (LAS bf16*)(c.lds + 3 * TILE_B + 4096);
        const bf16* sbase = WSP(bf16, WS_SSTB) + (size_t)sc * 8192 + 8 * c.tid;
        const size_t sd0 = (size_t)(((b * 2 + 0) * 4 + 2 * g) * NSC) * 8192, sd1 = (size_t)(((b * 2 + 1) * 4 + 2 * g) * NSC) * 8192, shd = (size_t)NSC * 8192;
        u32x4 sa0 = *(const u32x4*)(sbase + sd0), sa1 = *(const u32x4*)(sbase + sd0 + 4096), sb0 = *(const u32x4*)(sbase + sd1), sb1 = *(const u32x4*)(sbase + sd1 + 4096);
        LAS bf16* stw = St + (c.tid >> 4) * LD + 8 * (c.tid & 15);
        LAS float* wtab = (LAS float*)St;
        { const int chs[3] = {128 * g, 256 + 128 * g, 512 + 128 * g}; conv_wt_load<3>(c, cw, cb, chs, wtab); }
        __syncthreads();
        conv_load(c, proj, wtab, seqbase, t0, slen, 128 * g, Xs);
        conv_load(c, proj, wtab + 768, seqbase, t0, slen, 256 + 128 * g, Bs);
        conv_load(c, proj, wtab + 1536, seqbase, t0, slen, 512 + 128 * g, Cs);
        __syncthreads();
        *(LAS u32x4*)stw = sa0; *(LAS u32x4*)(stw + 32 * LD) = sa1; *(LAS u32x4*)(stw + 64 * LD) = sb0; *(LAS u32x4*)(stw + 96 * LD) = sb1;
        if (c.wave < 4) {
            const int combo = c.wave, dir = combo >> 1, h = 2 * g + (combo & 1), dh = dir * 4 + h;
            const float ac = -__expf(a.in[I_ALOG][layer * 8 + dh]), dtb = a.in[I_DTB][layer * 8 + dh];
            const int ta = dir ? 127 - 2 * c.lane : 2 * c.lane, tb = dir ? 126 - 2 * c.lane : 2 * c.lane + 1;
            const float dta = softplusf(gates[(size_t)dh * NTOK + rowbase + ta] + dtb), dtb2 = softplusf(gates[(size_t)dh * NTOK + rowbase + tb] + dtb);
            const float la = dta * ac, lb = dtb2 * ac, s = la + lb, incl = scan_add(s, c.lane), excl = incl - s;
            acum[combo * 128 + ta] = excl + la; acum[combo * 128 + tb] = incl; dtv[combo * 128 + ta] = dta; dtv[combo * 128 + tb] = dtb2;
        }
        __syncthreads();
        f32x4 accY[2][4];
#pragma unroll
        for (int hh = 0; hh < 2; ++hh)
#pragma unroll
            for (int pb = 0; pb < 4; ++pb) accY[hh][pb] = (f32x4){0.f, 0.f, 0.f, 0.f};
        sa0 = *(const u32x4*)(sbase + sd0 + shd); sa1 = *(const u32x4*)(sbase + sd0 + shd + 4096); sb0 = *(const u32x4*)(sbase + sd1 + shd); sb1 = *(const u32x4*)(sbase + sd1 + shd + 4096);
        f32x4 accG[8];
#pragma unroll
        for (int jb = 0; jb < 8; ++jb) accG[jb] = (f32x4){0.f, 0.f, 0.f, 0.f};
#pragma unroll
        for (int ks = 0; ks < 4; ++ks) { const bf16x8 cq = frag_kc(Cs, LD, 16 * c.wave, 32 * ks, c.lane);
#pragma unroll
            for (int jb = 0; jb < 8; ++jb) accG[jb] = mfma16(frag_kc(Bs, LD, 16 * jb, 32 * ks, c.lane), cq, accG[jb]); }
#pragma unroll
        for (int cc = 0; cc < 4; ++cc) {
            asm volatile("" ::: "memory");
            const int hh = cc >> 1, dir = cc & 1, combo = dir * 2 + hh;
            if (cc == 2) { __syncthreads(); *(LAS u32x4*)stw = sa0; *(LAS u32x4*)(stw + 32 * LD) = sa1; *(LAS u32x4*)(stw + 64 * LD) = sb0; *(LAS u32x4*)(stw + 96 * LD) = sb1; __syncthreads(); }
            const float ai = acum[combo * 128 + irow];
            {
                f32x4 accI[4];
#pragma unroll
                for (int pb = 0; pb < 4; ++pb) accI[pb] = (f32x4){0.f, 0.f, 0.f, 0.f};
#pragma unroll
                for (int ks = 0; ks < 4; ++ks) { const bf16x8 cq = frag_kc(Cs, LD, 16 * c.wave, 32 * ks, c.lane);
#pragma unroll
                    for (int pb = 0; pb < 4; ++pb) accI[pb] = mfma16(frag_kc(St + dir * 64 * LD, LD, 16 * pb, 32 * ks, c.lane), cq, accI[pb]); }
                const float ei = __expf(ai);
#pragma unroll
                for (int pb = 0; pb < 4; ++pb) accY[hh][pb] += accI[pb] * ei;
            }
#pragma unroll
            for (int jp = 0; jp < 4; ++jp) {
                asm volatile("" ::: "memory");
                const bool skip = dir == 0 ? (2 * jp > c.wave) : (2 * jp + 1 < c.wave);
                if (!skip) {
                    const int j0 = 32 * jp + 4 * gq;
                    const f32x4 aa = *(const LAS f32x4*)(acum + combo * 128 + j0), ab = *(const LAS f32x4*)(acum + combo * 128 + j0 + 16);
                    const f32x4 da = *(const LAS f32x4*)(dtv + combo * 128 + j0), db = *(const LAS f32x4*)(dtv + combo * 128 + j0 + 16);
                    f32x4 wa, wb;
#pragma unroll
                    for (int r = 0; r < 4; ++r) { const int ja = j0 + r, jb2 = j0 + 16 + r;
                        const bool ma = dir == 0 ? (ja <= irow) : (ja >= irow), mb = dir == 0 ? (jb2 <= irow) : (jb2 >= irow);
                        wa[r] = ma ? __expf(ai - aa[r]) * da[r] : 0.f; wb[r] = mb ? __expf(ai - ab[r]) * db[r] : 0.f; }
                    const bf16x8 pf = pack_acc(accG[2 * jp] * wa, accG[2 * jp + 1] * wb);
#pragma unroll
                    for (int pb = 0; pb < 4; ++pb) accY[hh][pb] = mfma16(frag_trp(Xs, LD, 32 * jp, 64 * hh + 16 * pb, c.lane), pf, accY[hh][pb]);
                }
            }
        }
#pragma unroll
        for (int hh = 0; hh < 2; ++hh) { const int h = 2 * g + hh; const float dsk = a.in[I_SSMD][layer * 8 + h] + a.in[I_SSMD][layer * 8 + 4 + h];
#pragma unroll
            for (int q = 0; q < 2; ++q) { u32x2 wp[2], zp[2];
                { const int sel = gq & 1; narrow16(*(const u32x4*)(proj + row * NPROJ + C_Z + h * 64 + 32 * q + 16 * sel + 4 * (gq - sel)), zp[0], zp[1]); }
#pragma unroll
                for (int pp = 0; pp < 2; ++pp) { const int pb = 2 * q + pp; const u32x2 xr = *(const LAS u32x2*)(Xs + irow * LD + 64 * hh + 16 * pb + 4 * gq);
                    const u32x2 zr = zp[pp];
                    f32x4 v = accY[hh][pb] + (f32x4){bflo(xr.x), bfhi(xr.x), bflo(xr.y), bfhi(xr.y)} * dsk;
                    v.x *= siluf(bflo(zr.x)); v.y *= siluf(bfhi(zr.x)); v.z *= siluf(bflo(zr.y)); v.w *= siluf(bfhi(zr.y));
                    ssq += (v.x * v.x + v.y * v.y) + (v.z * v.z + v.w * v.w);
                    wp[pp].x = pk2(v.x, v.y); wp[pp].y = pk2(v.z, v.w); }
                const int sel = gq & 1;
                *(u32x4*)(mix + row * 1024 + 512 + h * 64 + 32 * q + 16 * sel + 4 * (gq - sel)) = widen16(wp[0], wp[1]); } }
    }
    ssq = col4_sum(ssq);
    const float rstd = rsqrtf(ssq * (1.f / 256.f) + EPS);
    asm volatile("s_waitcnt vmcnt(0)" ::: "memory");
#pragma unroll
    for (int hq = 0; hq < 4; ++hq)
#pragma unroll
        for (int q = 0; q < 2; ++q) { const int sel = gq & 1, ch = hq * 64 + 32 * q + 16 * sel + 4 * (gq - sel); const LAS float* gp = gtab + ch; const f32x4 g0 = *(const LAS f32x4*)gp, g1 = *(const LAS f32x4*)(gp + 4);
            u32x4* p = (u32x4*)(mix + row * 1024 + 512 + ch); const u32x4 vr = *p;
            u32x4 w; w.x = pk2(bflo(vr.x) * rstd * g0.x, bfhi(vr.x) * rstd * g0.y); w.y = pk2(bflo(vr.y) * rstd * g0.z, bfhi(vr.y) * rstd * g0.w);
            w.z = pk2(bflo(vr.z) * rstd * g1.x, bfhi(vr.z) * rstd * g1.y); w.w = pk2(bflo(vr.w) * rstd * g1.z, bfhi(vr.w) * rstd * g1.w); *p = w; }
    __syncthreads();
}

DI void ml_out_task(const Ctx& c0, const Args& a, int layer, int b, int sc, int hp) {
    Ctx c = c0; fresh_ctx(c);
    LAS bf16* Qs = (LAS bf16*)c.lds; LAS bf16* Ks = Qs + 128 * LD; LAS bf16* Vs = Ks + 128 * LD;
    LAS float* av = (LAS float*)(c.lds + 3 * TILE_B); LAS float* Mv = av + 512; LAS float* bcv = Mv + 512;
    const bf16* proj = WSP(bf16, WS_PROJ); const float* gates = WSP(float, WS_GATES); const float* misc = WSP(float, WS_MISC);
    int seqbase, t0, slen; chunk_info(b, sc, seqbase, t0, slen); const int rowbase = seqbase + t0;
    const float* rc = WSP(float, WS_ROPE); const float* rs = rc + 8192 * 32;
    LAS float* gtab = (LAS float*)(c.lds + 3 * TILE_B + 6144 + 2 * 64 * 72 * 2 + 512);
    if (c.tid < 32) *(LAS f32x4*)(gtab + 4 * c.tid) = *(const f32x4*)(a.in[I_MLG] + layer * 256 + 2 * hp * 64 + 4 * c.tid);
    ml_load_qk2(c, proj, rc, rs, rowbase, t0, sc >= 2, hp, Qs, Ks);
    ml_load_v(c, proj, rowbase, C_MLV, hp, Vs);
    if (c.wave < 4) {
        const int combo = c.wave, dir = combo >> 1, h = 2 * hp + (combo & 1), dh = dir * 4 + h;
        const float bi = a.in[I_MLGB][layer * 16 + dir * 8 + h], bfg = a.in[I_MLGB][layer * 16 + dir * 8 + 4 + h];
        const int ta = dir ? 127 - 2 * c.lane : 2 * c.lane, tb = dir ? 126 - 2 * c.lane : 2 * c.lane + 1;
        const float* ga = gates + rowbase + ta; const float* gb = gates + rowbase + tb;
        const float lia = ga[(size_t)(8 + dh) * NTOK] + bi, lib = gb[(size_t)(8 + dh) * NTOK] + bi, lfa = logsigf(ga[(size_t)(16 + dh) * NTOK] + bfg), lfb = logsigf(gb[(size_t)(16 + dh) * NTOK] + bfg);
        const float s = lfa + lfb, incl = scan_add(s, c.lane), excl = incl - s;
        const float bca = excl + lfa, bcb = incl, aa = lia - bca, ab = lib - bcb;
        const float im = scan_max(fmaxf(aa, ab), c.lane); float em = __shfl_up(im, 1); if (c.lane == 0) em = -INFINITY;
        const float m_in = misc[2 * NSIDX + ((b * 2 + dir) * 4 + h) * NSC + sc];
        av[combo * 128 + ta] = aa; av[combo * 128 + tb] = ab;
        Mv[combo * 128 + ta] = fmaxf(fmaxf(em, aa), m_in); Mv[combo * 128 + tb] = fmaxf(im, m_in);
        bcv[combo * 128 + ta] = bca; bcv[combo * 128 + tb] = bcb;
    }
    __syncthreads();
    const int ci = c.lane & 15, gq = c.lane >> 4, irow = 16 * c.wave + ci;
    const size_t row = (size_t)rowbase + irow; bf16* mix = WSP(bf16, WS_MIX);
#pragma unroll 1
    for (int hh = 0; hh < 2; ++hh) {
        fresh_ctx(c);
        const int ci = c.lane & 15, gq = c.lane >> 4, irow = 16 * c.wave + ci; const size_t row = (size_t)rowbase + irow;
        const int h = 2 * hp + hh;
        LAS bf16* StM = (LAS bf16*)(c.lds + 3 * TILE_B + 6144); LAS float* nvs = (LAS float*)(StM + 2 * 64 * 72);
        const int sx0 = ((b * 2 + 0) * 4 + h) * NSC + sc, sx1 = ((b * 2 + 1) * 4 + h) * NSC + sc;
        const u32x4 st0 = *(const u32x4*)(WSP(bf16, WS_MCB) + (size_t)sx0 * 4096 + 8 * c.tid), st1 = *(const u32x4*)(WSP(bf16, WS_MCB) + (size_t)sx1 * 4096 + 8 * c.tid);
        f32x4 nvr = (f32x4){0.f, 0.f, 0.f, 0.f}; if (c.tid < 32) nvr = *(const f32x4*)(misc + 8 * NSIDX + (size_t)(c.tid < 16 ? sx0 : sx1) * 64 + 4 * (c.tid & 15));
        f32x4 accH[4];
#pragma unroll
        for (int eb = 0; eb < 4; ++eb) accH[eb] = (f32x4){0.f, 0.f, 0.f, 0.f};
        f32x4 accS[8];
#pragma unroll
        for (int jb = 0; jb < 8; ++jb) accS[jb] = (f32x4){0.f, 0.f, 0.f, 0.f};
#pragma unroll
        for (int ks = 0; ks < 2; ++ks) { const bf16x8 qf = frag_kc(Qs, LD, 16 * c.wave, 64 * hh + 32 * ks, c.lane);
#pragma unroll
            for (int jb = 0; jb < 8; ++jb) accS[jb] = mfma16(frag_kc(Ks, LD, 16 * jb, 64 * hh + 32 * ks, c.lane), qf, accS[jb]); }
        if (hh) __syncthreads();
        *(LAS u32x4*)(StM + (c.tid >> 3) * 72 + 8 * (c.tid & 7)) = st0; *(LAS u32x4*)(StM + 64 * 72 + (c.tid >> 3) * 72 + 8 * (c.tid & 7)) = st1;
        if (c.tid < 32) *(LAS f32x4*)(nvs + 4 * c.tid) = nvr;
        __syncthreads();
#pragma unroll
        for (int dir = 0; dir < 2; ++dir) {
            asm volatile("" ::: "memory");
            const int combo = dir * 2 + hh, sidx = ((b * 2 + dir) * 4 + h) * NSC + sc;
            const float Mi = Mv[combo * 128 + irow], m_in = misc[2 * NSIDX + sidx], inter = __expf(m_in - Mi) * 0.125f;
            f32x4 accN[4], accC[4];
#pragma unroll
            for (int eb = 0; eb < 4; ++eb) { accN[eb] = (f32x4){0.f, 0.f, 0.f, 0.f}; accC[eb] = (f32x4){0.f, 0.f, 0.f, 0.f}; }
            float dsum = 0.f;
#pragma unroll
            for (int jp = 0; jp < 4; ++jp) {
                asm volatile("" ::: "memory");
                const bool skip = dir == 0 ? (2 * jp > c.wave) : (2 * jp + 1 < c.wave);
                if (!skip) {
                    const int j0 = 32 * jp + 4 * gq;
                    const f32x4 aa = *(const LAS f32x4*)(av + combo * 128 + j0), ab = *(const LAS f32x4*)(av + combo * 128 + j0 + 16);
                    f32x4 sa, sb;
#pragma unroll
                    for (int r = 0; r < 4; ++r) { const int ja = j0 + r, jb2 = j0 + 16 + r;
                        const bool ma = dir == 0 ? (ja <= irow) : (ja >= irow), mb = dir == 0 ? (jb2 <= irow) : (jb2 >= irow);
                        sa[r] = ma ? accS[2 * jp][r] * (__expf(aa[r] - Mi) * 0.125f) : 0.f; sb[r] = mb ? accS[2 * jp + 1][r] * (__expf(ab[r] - Mi) * 0.125f) : 0.f; }
                    dsum += (sa.x + sa.y) + (sa.z + sa.w) + (sb.x + sb.y) + (sb.z + sb.w);
                    const bf16x8 pf = pack_acc(sa, sb);
#pragma unroll
                    for (int eb = 0; eb < 4; ++eb) accN[eb] = mfma16(frag_trp(Vs, LD, 32 * jp, 64 * hh + 16 * eb, c.lane), pf, accN[eb]);
                }
            }
#pragma unroll
            for (int ks = 0; ks < 2; ++ks) { const bf16x8 qf = frag_kc(Qs, LD, 16 * c.wave, 64 * hh + 32 * ks, c.lane);
#pragma unroll
                for (int eb = 0; eb < 4; ++eb) accC[eb] = mfma16(frag_kc(StM + dir * 64 * 72, 72, 16 * eb, 32 * ks, c.lane), qf, accC[eb]); }
            const LAS float* nin = nvs + dir * 64 + 16 * gq;
            const u32x4 q0 = *(const LAS u32x4*)(Qs + irow * LD + 64 * hh + 16 * gq), q1 = *(const LAS u32x4*)(Qs + irow * LD + 64 * hh + 16 * gq + 8);
            const f32x4 n0 = *(const LAS f32x4*)nin, n1 = *(const LAS f32x4*)(nin + 4), n2 = *(const LAS f32x4*)(nin + 8), n3 = *(const LAS f32x4*)(nin + 12);
            float nq = bflo(q0.x) * n0.x + bfhi(q0.x) * n0.y + bflo(q0.y) * n0.z + bfhi(q0.y) * n0.w + bflo(q0.z) * n1.x + bfhi(q0.z) * n1.y + bflo(q0.w) * n1.z + bfhi(q0.w) * n1.w
                     + bflo(q1.x) * n2.x + bfhi(q1.x) * n2.y + bflo(q1.y) * n2.z + bfhi(q1.y) * n2.w + bflo(q1.z) * n3.x + bfhi(q1.z) * n3.y + bflo(q1.w) * n3.z + bfhi(q1.w) * n3.w;
            nq = col4_sum(nq);
            dsum = col4_sum(dsum);
            const float den = dsum + inter * nq, mi = bcv[combo * 128 + irow] + Mi;
            const float inv = __builtin_amdgcn_rcpf(fmaxf(fabsf(den), __expf(-mi)));
#pragma unroll
            for (int eb = 0; eb < 4; ++eb) accH[eb] += (accN[eb] + accC[eb] * inter) * inv;
        }
        { float ssq = 0.f;
#pragma unroll
        for (int q = 0; q < 2; ++q) { u32x2 op[2]; const int sel = gq & 1; narrow16(*(const u32x4*)(proj + row * NPROJ + C_MLO + h * 64 + 32 * q + 16 * sel + 4 * (gq - sel)), op[0], op[1]);
#pragma unroll
            for (int pp = 0; pp < 2; ++pp) { const int eb = 2 * q + pp; const u32x2 orw = op[pp];
                f32x4 v = accH[eb]; v.x *= sigmf(bflo(orw.x)); v.y *= sigmf(bfhi(orw.x)); v.z *= sigmf(bflo(orw.y)); v.w *= sigmf(bfhi(orw.y));
                accH[eb] = v; ssq += (v.x * v.x + v.y * v.y) + (v.z * v.z + v.w * v.w); } }
        ssq = col4_sum(ssq);
        const float rstd = rsqrtf(ssq * (1.f / 64.f) + EPS);
#pragma unroll
        for (int q = 0; q < 2; ++q) { u32x2 wp[2];
#pragma unroll
            for (int pp = 0; pp < 2; ++pp) { const int e = 16 * (2 * q + pp) + 4 * gq; const f32x4 gg = *(const LAS f32x4*)(gtab + hh * 64 + e);
                const f32x4 o = accH[2 * q + pp] * rstd * gg; wp[pp].x = pk2(o.x, o.y); wp[pp].y = pk2(o.z, o.w); }
            const int sel = gq & 1; *(u32x4*)(mix + row * 1024 + 768 + h * 64 + 32 * q + 16 * sel + 4 * (gq - sel)) = widen16(wp[0], wp[1]); } }
    }
    __syncthreads();
}


constexpr int CW_Q = 196608;
DI int q_pop_issue(const Ctx& c, unsigned* q) { int v = 0; if (c.tid == 0) v = c.G + (int)__hip_atomic_fetch_add(q, 1u, __ATOMIC_RELAXED, __HIP_MEMORY_SCOPE_AGENT); return v; }
DI void q_publish(const Ctx& c, int v, int slot) { if (c.tid == 0) ((volatile LAS int*)(c.lds + MISC_OFF))[16 + slot] = v; }
DI int q_read(const Ctx& c, int slot) { return __builtin_amdgcn_readfirstlane(((volatile LAS int*)(c.lds + MISC_OFF))[16 + slot]); }
constexpr int KVLD = 72, NA_NIT = 13;
struct NaTask { int b, h, rp, ctxq; };
DI NaTask na_decode(int u, int nA) { NaTask t; if (u < nA) { t.b = u >> 9; t.h = (u >> 6) & 7; t.rp = u & 63; t.ctxq = 0; } else { const int v = u - nA; t.b = v >> 4; t.h = (v >> 1) & 7; t.rp = v & 1; t.ctxq = 1; } return t; }
DI int na_rs(int rp) { const int r0a = 2 * rp < 4 ? 0 : (2 * rp > 124 ? 120 : 2 * rp - 4); return r0a > 119 ? 119 : r0a; }
DI void kv_issue(const Ctx& c, const bf16* proj, int col, int b, int rs, int nit, u32x4 (&raw)[NA_NIT]) {
    const int kq = c.tid >> 3, ch = c.tid & 7;
    const bf16* pc = proj + (size_t)(NLAT + b * CTXL + kq) * NPROJ + col + 8 * ch;
    const bf16* pw = proj + (size_t)(b * SEQ + rs * 64 + kq) * NPROJ + col + 8 * ch;
#pragma unroll
    for (int i = 0; i < NA_NIT; ++i) { raw[i] = (u32x4){0u, 0u, 0u, 0u};
        if (i < nit) raw[i] = i < 4 ? *(const u32x4*)(pc + (size_t)i * 64 * NPROJ) : *(const u32x4*)(pw + (size_t)(i - 4) * 64 * NPROJ); }
}
DI void kv_commit(const Ctx& c, int nit, LAS bf16* KV, u32x4 (&raw)[NA_NIT]) {
    LAS bf16* p = KV + (c.tid >> 3) * KVLD + 8 * (c.tid & 7);
#pragma unroll
    for (int i = 0; i < NA_NIT; ++i) if (i < nit) *(LAS u32x4*)(p + i * 64 * KVLD) = raw[i];
}
DI void na_softmax(f32x4 (&S)[16], float& m, float& l, bf16x8 (&P)[8]) {
    m = -INFINITY;
#pragma unroll
    for (int kb = 0; kb < 16; ++kb) m = fmaxf(m, fmaxf(fmaxf(S[kb].x, S[kb].y), fmaxf(S[kb].z, S[kb].w)));
    m = col4_max(m);
    l = 0.f;
#pragma unroll
    for (int kb = 0; kb < 16; ++kb) {
#pragma unroll
        for (int q = 0; q < 4; ++q) { const float p = __builtin_amdgcn_exp2f(S[kb][q] - m); S[kb][q] = p; l += p; } }
    l = col4_sum(l);
#pragma unroll
    for (int kp = 0; kp < 8; ++kp) P[kp] = pack_acc(S[2 * kp], S[2 * kp + 1]);
}
DI void na_tasks(const Ctx& c0, const Args& a, int layer, int u0, int u1, int nA, int nT, unsigned* q, int qofs) {
    Ctx c = c0; fresh_ctx(c);
    LAS bf16* KV = (LAS bf16*)c.lds; LAS float* rpbs = (LAS float*)(c.lds + 139264);
    const bf16* proj = WSP(bf16, WS_PROJ);
    u32x4 kvr[NA_NIT];
    if (u0 < nT) { const NaTask t = na_decode(u0, nA); kv_issue(c, proj, C_NAK + t.h * 64, t.b, na_rs(t.rp), t.ctxq ? 4 : NA_NIT, kvr); }
    int u = u0, un = u1;
    while (u < nT) {
        fresh_ctx(c);
        const int nn = q_pop_issue(c, q) - qofs;
        const int ci = c.lane & 15, gq = c.lane >> 4, rw = c.wave >> 2, qg = c.wave & 3, wq = 16 * qg + ci;
        const int cbase = qg == 0 ? 0 : (qg == 1 ? 8 : (qg == 2 ? 24 : 32));
        const NaTask t = na_decode(u, nA); const int b = t.b, h = t.h, rs = na_rs(t.rp), nit = t.ctxq ? 4 : NA_NIT;
        const bool ctxq = t.ctxq != 0;
        const int r = 2 * t.rp + rw, r0 = r < 4 ? 0 : (r > 124 ? 120 : r - 4), ioff = r0 - rs;
        if (!ctxq) for (int i = c.tid; i < 465; i += NTHR) rpbs[i] = a.in[I_RPB][(layer * 8 + h) * 465 + i] * LOG2E;
        const size_t qrow = ctxq ? (size_t)NLAT + b * CTXL + t.rp * 128 + 16 * c.wave + ci : (size_t)b * SEQ + r * 64 + wq;
        bf16x8 qf[2];
        { const bf16* qs = proj + qrow * NPROJ + C_NAQ + h * 64; qf[0] = *(const bf16x8*)(qs + 8 * gq); qf[1] = *(const bf16x8*)(qs + 32 + 8 * gq); }
        kv_commit(c, nit, KV, kvr);
        __syncthreads();
        float m1, l1, m2 = -INFINITY, l2 = 0.f; bf16x8 P1[8], P2[8];
        {
            f32x4 S[16];
#pragma unroll
            for (int kb = 0; kb < 16; ++kb) { if ((kb & 3) == 0) asm volatile("" ::: "memory"); S[kb] = mfma16(frag_kc(KV, KVLD, 16 * kb, 0, c.lane), qf[0], (f32x4){0.f, 0.f, 0.f, 0.f}); S[kb] = mfma16(frag_kc(KV, KVLD, 16 * kb, 32, c.lane), qf[1], S[kb]); }
            na_softmax(S, m1, l1, P1);
        }
        kv_issue(c, proj, C_NAV + h * 64, b, rs, nit, kvr);
        const int wrow = 256 + ioff * 64 + cbase;
        if (!ctxq) {
            f32x4 S[16];
#pragma unroll
            for (int kb = 0; kb < 16; ++kb) { if ((kb & 3) == 0) asm volatile("" ::: "memory"); const int row0 = wrow + (kb >> 1) * 64 + 16 * (kb & 1);
                S[kb] = mfma16(frag_kc(KV, KVLD, row0, 0, c.lane), qf[0], (f32x4){0.f, 0.f, 0.f, 0.f}); S[kb] = mfma16(frag_kc(KV, KVLD, row0, 32, c.lane), qf[1], S[kb]); }
            const int cw0 = wq < 8 ? 0 : (wq > 56 ? 48 : wq - 8);
#pragma unroll
            for (int kb = 0; kb < 16; ++kb) { if ((kb & 3) == 0) asm volatile("" ::: "memory"); const int dr = r0 + (kb >> 1) - r + 7;
#pragma unroll
                for (int q = 0; q < 4; ++q) { const int kc = cbase + 16 * (kb & 1) + 4 * gq + q; const bool valid = kc >= cw0 && kc < cw0 + 16;
                    const int dc = kc - wq + 15;
                    S[kb][q] = valid ? S[kb][q] + rpbs[dr * 31 + dc] : -INFINITY; } }
            na_softmax(S, m2, l2, P2);
        }
        __syncthreads();
        kv_commit(c, nit, KV, kvr);
        __syncthreads();
        if (un < nT) { const NaTask tn = na_decode(un, nA); kv_issue(c, proj, C_NAK + tn.h * 64, tn.b, na_rs(tn.rp), tn.ctxq ? 4 : NA_NIT, kvr); }
        f32x4 O1[4], O2[4];
#pragma unroll
        for (int db = 0; db < 4; ++db) { O1[db] = (f32x4){0.f, 0.f, 0.f, 0.f}; O2[db] = (f32x4){0.f, 0.f, 0.f, 0.f}; }
#pragma unroll
        for (int kp = 0; kp < 8; ++kp) { asm volatile("" ::: "memory");
#pragma unroll
            for (int db = 0; db < 4; ++db) O1[db] = mfma16(frag_trp(KV, KVLD, 32 * kp, 16 * db, c.lane), P1[kp], O1[db]); }
        if (!ctxq) {
#pragma unroll
            for (int kp = 0; kp < 8; ++kp) { asm volatile("" ::: "memory");
#pragma unroll
                for (int db = 0; db < 4; ++db) O2[db] = mfma16(frag_trp(KV, KVLD, wrow + 64 * kp, 16 * db, c.lane), P2[kp], O2[db]); }
        }
        {
            const float M = fmaxf(m1, m2), f1 = __builtin_amdgcn_exp2f(m1 - M), f2 = __builtin_amdgcn_exp2f(m2 - M), inv = __builtin_amdgcn_rcpf(l1 * f1 + l2 * f2);
            bf16* dst = WSP(bf16, WS_MIX) + qrow * 1024 + h * 64 + 4 * gq;
#pragma unroll
            for (int q = 0; q < 2; ++q) { const f32x4 oa = (O1[2 * q] * f1 + O2[2 * q] * f2) * inv, ob = (O1[2 * q + 1] * f1 + O2[2 * q + 1] * f2) * inv;
                u32x2 wa, wb; wa.x = pk2(oa.x, oa.y); wa.y = pk2(oa.z, oa.w); wb.x = pk2(ob.x, ob.y); wb.y = pk2(ob.z, ob.w);
                const int sel = gq & 1; *(u32x4*)(dst + 32 * q + 16 * sel - 4 * sel) = widen16(wa, wb); }
        }
        q_publish(c, nn, 0);
        __syncthreads();
        u = un; un = q_read(c, 0);
    }
}
#ifndef SUB6
#define SUB6 7
#endif
DI void phase_outputs(const Ctx& c, const Args& a, int layer, int sub, int qid) {
    const int sc_lo = layer == 0 ? 0 : 2, nsc = NSC - sc_lo, nS = NB * nsc, nM = 2 * nS, nA = NB * 8 * 64, nC = layer == 0 ? NB * 8 * 2 : 0, nH = nS + nM, nT = nH + nA + nC;
    unsigned* q = WSP(unsigned, WS_CTL) + CW_Q + 64 * qid;
    int cur = blockIdx.x + ((sub & 3) ? 0 : nH), nxt;
    { const int v = q_pop_issue(c, q) + ((sub & 3) ? 0 : nH); q_publish(c, v, 0); __syncthreads(); nxt = q_read(c, 0); __syncthreads(); }
    if (!(sub & 4) && cur >= nH) return;
    while (cur < nH) {
        const int nn = q_pop_issue(c, q);
        if (cur < nS) { if (sub & 1) ssd_out_task(c, a, layer, cur / nsc, sc_lo + cur % nsc); }
        else { const int u = cur - nS, b = u / (2 * nsc), rem = u % (2 * nsc); if (sub & 2) ml_out_task(c, a, layer, b, sc_lo + (rem >> 1), rem & 1); }
        q_publish(c, nn, 0); __syncthreads(); cur = nxt; nxt = q_read(c, 0); __syncthreads();
    }
    if (sub & 4) na_tasks(c, a, layer, cur - nH, nxt - nH, nA, nT - nH, q, (sub & 3) ? nH : 0);
}

DI void phase_norm2_router(const Ctx& c, const Args& a, int layer, int M, int dummy, int qid, unsigned* ctxdone) {
    constexpr int LDV = 1032;
    LAS bf16* vhi = (LAS bf16*)c.lds; LAS bf16* vlo = vhi + 32 * LDV;
    LAS float* P = (LAS float*)c.lds;
    LAS float* lg = (LAS float*)(c.lds + 132096);
    LAS int* lcnt = (LAS int*)(c.lds + 136320); LAS int* lbase = lcnt + 32; LAS int* sel = lcnt + 64; LAS int* selr = sel + 128; LAS float* selw = (LAS float*)(selr + 128);
    const float* mod = WSP(float, WS_MOD); const bf16* H = WSP(bf16, WS_H); unsigned char* U8 = WSP(unsigned char, WS_U);
    const float* ng = a.in[I_NORMG] + (layer * 2 + 1) * 1024; const float* rb = a.in[I_RB] + layer * 32;
    unsigned* cnt = WSP(unsigned, WS_CTL) + CW_CNT + layer * 32 + dummy * 128;
    int* tok_e = WSP(int, WS_ROUTE); int* tok_slot = tok_e + NTOK * 4; float* tok_w = (float*)(tok_slot + NTOK * 4);
    int* etok = (int*)(WSP(unsigned char, WS_ACT) + (size_t)MPAD * 1024);
    const int ci = c.lane & 15, gq = c.lane >> 4;
    bf16x8 whi[4][2], wlo[4][2];
    { const bf16* rwt = WSP(bf16, WS_RWT) + (size_t)layer * 2 * 32 * 1024;
#pragma unroll
      for (int ks = 0; ks < 4; ++ks)
#pragma unroll
        for (int eb = 0; eb < 2; ++eb) { const bf16* p = rwt + (16 * eb + ci) * 1024 + 128 * c.wave + 32 * ks + 8 * gq; whi[ks][eb] = *(const bf16x8*)p; wlo[ks][eb] = *(const bf16x8*)(p + 32 * 1024); } }
    unsigned* q = WSP(unsigned, WS_CTL) + CW_Q + 64 * qid;
    int tile, tnext;
    { const int v = q_pop_issue(c, q) - c.G; q_publish(c, v, 0); __syncthreads(); tile = q_read(c, 0); __syncthreads(); }
    { const int v = q_pop_issue(c, q) - c.G; q_publish(c, v, 0); __syncthreads(); tnext = q_read(c, 0); __syncthreads(); }
    while (tile < M / 32) {
        const int tnn = q_pop_issue(c, q) - c.G;
        if (ctxdone && tile >= NLAT / 32) {
            if (c.tid == 0) { unsigned sp = 0; while (__hip_atomic_load(ctxdone, __ATOMIC_RELAXED, __HIP_MEMORY_SCOPE_AGENT) < 16u) { __builtin_amdgcn_s_sleep(2); if (++sp > (1u << 22)) break; }
                __builtin_amdgcn_fence(__ATOMIC_ACQUIRE, "agent"); asm volatile("s_waitcnt vmcnt(0)" ::: "memory"); }
            __syncthreads();
        }
        {
            f32x4 v[4][4]; float ss[4];
#pragma unroll
            for (int rr = 0; rr < 4; ++rr) { const int row = tile * 32 + c.wave * 4 + rr; ss[rr] = 0.f;
#pragma unroll
                for (int j = 0; j < 4; ++j) { const u32x2 hv = *(const u32x2*)(H + (size_t)row * 1024 + 4 * (c.lane + 64 * j)); v[rr][j] = (f32x4){bflo(hv.x), bfhi(hv.x), bflo(hv.y), bfhi(hv.y)}; ss[rr] += (v[rr][j].x * v[rr][j].x + v[rr][j].y * v[rr][j].y) + (v[rr][j].z * v[rr][j].z + v[rr][j].w * v[rr][j].w); } }
#pragma unroll
            for (int rr = 0; rr < 4; ++rr) {
                const int lrow = c.wave * 4 + rr, row = tile * 32 + lrow, r = row < NLAT ? row >> 13 : 4;
                const float* m = mod + (layer * 5 + r) * 6144;
                const float rstd = rsqrtf(wave_sum(ss[rr]) * (1.f / 1024.f) + EPS);
#pragma unroll
                for (int j = 0; j < 4; ++j) { const int col = 4 * (c.lane + 64 * j);
                    const f32x4 g = *(const f32x4*)(ng + col), sh = *(const f32x4*)(m + 3 * 1024 + col), scl = *(const f32x4*)(m + 4 * 1024 + col);
                    const f32x4 o = (v[rr][j] * rstd * g) * (scl + 1.f) + sh;
                    u32x2 w; w.x = pk2(o.x, o.y); w.y = pk2(o.z, o.w); *(unsigned*)(U8 + (size_t)row * 1024 + col) = pk4_fp8(o.x, o.y, o.z, o.w);
                    *(LAS u32x2*)(vhi + lrow * LDV + col) = w;
                    u32x2 wl; wl.x = pk2(o.x - bflo(w.x), o.y - bfhi(w.x)); wl.y = pk2(o.z - bflo(w.y), o.w - bfhi(w.y));
                    *(LAS u32x2*)(vlo + lrow * LDV + col) = wl; }
            }
        }
        __syncthreads();
        f32x4 acc[2][2];
#pragma unroll
        for (int eb = 0; eb < 2; ++eb)
#pragma unroll
            for (int tb = 0; tb < 2; ++tb) acc[eb][tb] = (f32x4){0.f, 0.f, 0.f, 0.f};
#pragma unroll
        for (int ks = 0; ks < 4; ++ks) {
            bf16x8 bh[2], bl[2];
#pragma unroll
            for (int tb = 0; tb < 2; ++tb) { bh[tb] = frag_kc(vhi, LDV, 16 * tb, 128 * c.wave + 32 * ks, c.lane); bl[tb] = frag_kc(vlo, LDV, 16 * tb, 128 * c.wave + 32 * ks, c.lane); }
#pragma unroll
            for (int eb = 0; eb < 2; ++eb)
#pragma unroll
                for (int tb = 0; tb < 2; ++tb) { acc[eb][tb] = mfma16(whi[ks][eb], bh[tb], acc[eb][tb]); acc[eb][tb] = mfma16(whi[ks][eb], bl[tb], acc[eb][tb]); acc[eb][tb] = mfma16(wlo[ks][eb], bh[tb], acc[eb][tb]); }
        }
        __syncthreads();
#pragma unroll
        for (int eb = 0; eb < 2; ++eb)
#pragma unroll
            for (int tb = 0; tb < 2; ++tb) *(LAS f32x4*)(P + (c.wave * 32 + 16 * tb + ci) * 36 + 16 * eb + 4 * gq) = acc[eb][tb];
        __syncthreads();
        { const int tok = c.tid >> 4, e0 = (c.tid & 15) * 2; float s0 = rb[e0], s1 = rb[e0 + 1];
#pragma unroll
          for (int w8 = 0; w8 < 8; ++w8) { const f32x2 p = *(const LAS f32x2*)(P + (w8 * 32 + tok) * 36 + e0); s0 += p.x; s1 += p.y; }
          lg[tok * 33 + e0] = s0; lg[tok * 33 + e0 + 1] = s1;
          if (c.tid < 32) lcnt[c.tid] = 0; }
        __syncthreads();
#pragma unroll
        for (int tt = 0; tt < 4; ++tt) {
            const int tok = 4 * c.wave + tt; float x = c.lane < 32 ? lg[tok * 33 + c.lane] : -INFINITY;
            float vals[4]; int ids[4];
#pragma unroll
            for (int k = 0; k < 4; ++k) { const float mx = wave_max(x); const unsigned long long bal = __ballot(x == mx); const int idx = __ffsll((long long)bal) - 1; vals[k] = mx; ids[k] = idx; if (c.lane == idx) x = -INFINITY; }
            float wv[4], den = 0.f;
#pragma unroll
            for (int k = 0; k < 4; ++k) { wv[k] = __expf(vals[k] - vals[0]); den += wv[k]; }
            if (c.lane < 4) { const int id = c.lane == 0 ? ids[0] : (c.lane == 1 ? ids[1] : (c.lane == 2 ? ids[2] : ids[3]));
                const float wk = (c.lane == 0 ? wv[0] : (c.lane == 1 ? wv[1] : (c.lane == 2 ? wv[2] : wv[3]))) / den;
                sel[tok * 4 + c.lane] = id; selw[tok * 4 + c.lane] = wk; selr[tok * 4 + c.lane] = __hip_atomic_fetch_add(&lcnt[id], 1, __ATOMIC_RELAXED, __HIP_MEMORY_SCOPE_WORKGROUP); }
        }
        __syncthreads();
        if (c.tid < 32) { const int n = lcnt[c.tid]; lbase[c.tid] = n ? (int)__hip_atomic_fetch_add(cnt + c.tid, (unsigned)n, __ATOMIC_RELAXED, __HIP_MEMORY_SCOPE_AGENT) : 0; }
        __syncthreads();
        if (c.tid < 128) { const int id = sel[c.tid], o = tile * 128 + c.tid, slot = lbase[id] + selr[c.tid]; tok_e[o] = id; tok_slot[o] = slot; tok_w[o] = selw[c.tid];
            if (!dummy) etok[(size_t)id * ECAP + slot] = o >> 2; }
        q_publish(c, tnn, 0);
        __syncthreads();
        tile = tnext; tnext = q_read(c, 0);
    }
}
DI void phase_gather(const Ctx& c, int layer, int M) {
    LAS int* pbase = (LAS int*)c.lds;
    const unsigned* cnt = WSP(unsigned, WS_CTL) + CW_CNT + layer * 32;
    const int* tok_e = WSP(int, WS_ROUTE); const int* tok_slot = tok_e + NTOK * 4;
    if (c.tid == 0) { int s = 0; for (int e = 0; e < 32; ++e) { pbase[e] = s; s += ((int)cnt[e] + 255) & ~255; } pbase[32] = s; }
    __syncthreads();
    const unsigned char* U8 = WSP(unsigned char, WS_U); unsigned char* XP8 = WSP(unsigned char, WS_ACT);
    for (int pair = blockIdx.x * NWAVES + c.wave; pair < M * 4; pair += c.G * NWAVES) {
        const int tok = pair >> 2, prow = pbase[tok_e[pair]] + tok_slot[pair];
        const u32x4* s = (const u32x4*)(U8 + (size_t)tok * 1024); u32x4* d = (u32x4*)(XP8 + (size_t)MPAD * 1024 + (size_t)prow * 1024);
        d[c.lane] = s[c.lane];
    }
    __syncthreads();
}
DI int build_tiles(const Ctx& c, int layer, LAS int* tile_e) {
    const unsigned* cnt = WSP(unsigned, WS_CTL) + CW_CNT + layer * 32;
    int s = 0, mine = -1;
    for (int e = 0; e < 32; ++e) { const int n = ((int)cnt[e] + 255) >> 8; if (c.tid >= s && c.tid < s + n) mine = e; s += n; }
    if (s > MAXTILES) s = MAXTILES;
    if (c.tid < s && c.tid < NTHR) { tile_e[c.tid] = mine; int s3 = 0; for (int e = 0; e < mine; ++e) s3 += ((int)cnt[e] + 255) >> 8; tile_e[MAXTILES + c.tid] = (c.tid - s3) * 256; }
    if (c.tid + NTHR < s) { int s2 = 0, m2 = -1; const int t2 = c.tid + NTHR; for (int e = 0; e < 32; ++e) { const int n = ((int)cnt[e] + 255) >> 8; if (t2 >= s2 && t2 < s2 + n) m2 = e; s2 += n; } tile_e[t2] = m2; int s3 = 0; for (int e = 0; e < m2; ++e) s3 += ((int)cnt[e] + 255) >> 8; tile_e[MAXTILES + t2] = (t2 - s3) * 256; }
    __syncthreads();
    return s;
}
DI void phase_final(const Ctx& c, const Args& a) {
    const float* mod = WSP(float, WS_MOD);
    LAS int* pbase = (LAS int*)c.lds; build_pbase(c, 1, pbase);
    COMB_PIPE_BEGIN(NLAT, true)
        f32x4 v[4]; comb_reduce(c, r0, yc, hc, mod + (1 * 5 + (row >> 13)) * 6144 + 5 * 1024, v);
#pragma unroll
        for (int j = 0; j < 4; ++j) __builtin_nontemporal_store(v[j], (f32x4*)(a.out + (size_t)row * 1024 + 4 * (c.lane + 64 * j)));
    COMB_PIPE_END()
    __syncthreads();
}

__global__ void __launch_bounds__(NTHR, 2) fwd(Args a) {
    extern __shared__ __attribute__((aligned(16))) unsigned char lds_raw[];
    Ctx c; c.lds = (LAS unsigned char*)lds_raw; c.tid = threadIdx.x; c.lane = c.tid & 63; c.wave = __builtin_amdgcn_readfirstlane(c.tid >> 6); c.G = gridDim.x; c.ws = a.ws;
    volatile LAS unsigned* MISC = (volatile LAS unsigned*)(c.lds + MISC_OFF);
    if (c.tid < 64) MISC[c.tid] = 0u;
    __syncthreads();
    XcdBarrier bar = xcd_barrier_post(WSP(unsigned, WS_CTL) + CW_BAR + a.li * XCD_BAR_WORDS, MISC + 8);
    const int lo = a.ph_lo, hi = a.ph_hi;
    const int vcu = (c.G % 8 == 0) ? ((int)blockIdx.x % 8) * (c.G / 8) + (int)blockIdx.x / 8 : (int)blockIdx.x;
#ifndef PT_MASK
#define PT_MASK 0xFFFF
#endif
#define PT(t) ((PT_MASK >> (t)) & 1)
#ifndef DUP_MASK
#define DUP_MASK 0
#endif
#define DUP(t) ((DUP_MASK >> (t)) & 1)
#ifndef DUPN
#define DUPN 1
#endif
#ifndef DUP6_SUB
#define DUP6_SUB 7
#endif
#define IN(k) (fresh_ctx(c), (lo <= (k) && (k) < hi))
#define SEAM(k) do { if (IN(k) && IN((k) + 1)) xcd_barrier(bar); } while (0)
    if (PT(0) && IN(0)) { phase_ada(c, a); if (DUP(0)) { xcd_barrier(bar); phase_ada(c, a); } }
    SEAM(0);
    if (PT(1) && IN(1)) { phase_convert(c, a); if (DUP(1)) { xcd_barrier(bar); phase_convert(c, a); } }
    if (PT(2) && IN(1)) phase_norm1(c, a, 0);
    SEAM(1);
    for (int layer = 0; layer < DEPTH; ++layer) {
        const int pb = 2 + 10 * layer, M = layer == 0 ? NTOK : NLAT;
        if (layer > 0) { if (PT(2) && IN(pb + 0)) phase_norm1(c, a, layer); SEAM(pb + 0); }
        if (PT(3) && IN(pb + 1)) for (int rep = 0; rep < 1 + DUPN * DUP(3); ++rep) {
            if (rep) xcd_barrier(bar);
            pg8::Gemm g{WSP(bf16, WS_U), WSP(bf16, WS_WIN) + (size_t)layer * NPAD * 1024, NTOK, NPAD, 1024}; pg8::StaticOrder S; S.init(NTOK, NPAD, c.G, (int)blockIdx.x);
            EpiProj E{WSP(bf16, WS_PROJ), WSP(float, WS_GATES), a.in[I_QKG] + layer * 128};
            pg8::gemm_phase<EpiProj, pg8::StaticOrder, true, true>(c.lds, g, S, E);
        }
        SEAM(pb + 1);
        if (PT(4) && IN(pb + 2)) phase_local(c, a, layer, layer * 4 + 2);
        SEAM(pb + 2);
        if (PT(5) && IN(pb + 3)) phase_scan(c);
        if (DUP(4)) { xcd_barrier(bar); phase_local(c, a, layer, layer * 4 + 3); xcd_barrier(bar); phase_scan(c); }

        SEAM(pb + 3);
        if (PT(6) && IN(pb + 4)) { phase_outputs(c, a, layer, 7, layer * 4 + 0); if (DUP(6)) { xcd_barrier(bar); phase_outputs(c, a, layer, DUP6_SUB, layer * 4 + 1); } }
        SEAM(pb + 4);
        if (PT(7) && IN(pb + 5)) {
            pg8::Gemm g{WSP(bf16, WS_MIX), WSP(bf16, WS_WOUT) + (size_t)layer * 1024 * 1024, NLAT, 1024, 1024}; pg8::StaticOrder S; S.init(NLAT, 1024, c.G, (int)blockIdx.x);
            EpiRes E{WSP(bf16, WS_H), WSP(float, WS_MOD) + layer * 5 * 6144 + 2 * 1024, a.in[I_X], a.in[I_CTX], layer};
            pg8::gemm_phase<EpiRes, pg8::StaticOrder, true, true>(c.lds, g, S, E);
        }
        SEAM(pb + 5);
        if (PT(8) && IN(pb + 6)) {
            unsigned* ctxdone = WSP(unsigned, WS_CTL) + 200704;
            if (layer == 0) {
                for (int cu = blockIdx.x; cu < 16; cu += c.G) {
                    pg8::Gemm g{WSP(bf16, WS_MIX), WSP(bf16, WS_WOUT), NTOK, 1024, 1024}; OneUnit S{128 + (cu >> 2), cu & 3};
                    EpiRes E{WSP(bf16, WS_H), WSP(float, WS_MOD) + 2 * 1024, a.in[I_X], a.in[I_CTX], 0};
                    pg8::gemm_phase<EpiRes, OneUnit, true, true>(c.lds, g, S, E);
                    asm volatile("s_waitcnt vmcnt(0)" ::: "memory");
                    __syncthreads();
                    if (c.tid == 0) { __builtin_amdgcn_fence(__ATOMIC_RELEASE, "agent"); asm volatile("s_waitcnt vmcnt(0)" ::: "memory");
                        __hip_atomic_fetch_add(ctxdone, 1u, __ATOMIC_RELAXED, __HIP_MEMORY_SCOPE_AGENT); }
                    __syncthreads();
                }
            }
            phase_norm2_router(c, a, layer, M, 0, 8 + layer, layer == 0 ? ctxdone : nullptr);
        }
        SEAM(pb + 6);
        if (PT(10) && IN(pb + 8)) for (int rep = 0; rep < 1 + DUPN * DUP(10); ++rep) {
            if (rep) xcd_barrier(bar);
            LAS int* tile_e = (LAS int*)(c.lds + LDS_TILE_OFF); const int nt = __builtin_amdgcn_readfirstlane(build_tiles(c, layer, tile_e));
            pg8::Gemm g{(const pg8::bf16_t*)WSP(unsigned char, WS_U), (const pg8::bf16_t*)(WSP(unsigned char, WS_W1) + (size_t)layer * 32 * 2048 * 1024), MPAD, 2048, 512};
            MoeOrder S{tile_e, nt, 3, c.G, vcu, (const int*)(WSP(unsigned char, WS_ACT) + (size_t)MPAD * 1024), WSP(unsigned, WS_CTL) + CW_CNT + layer * 32};
            EpiSwiglu E{WSP(unsigned char, WS_ACT), a.in[I_B1] + (size_t)layer * 32 * 2048};
            pg8::gemm_phase<EpiSwiglu, MoeOrder, true, true, true, true>(c.lds, g, S, E);
        }
        SEAM(pb + 8);
        if (PT(11) && IN(pb + 9)) for (int rep = 0; rep < 1 + DUPN * DUP(11); ++rep) {
            if (rep) xcd_barrier(bar);
            LAS int* tile_e = (LAS int*)(c.lds + LDS_TILE_OFF); const int nt = __builtin_amdgcn_readfirstlane(build_tiles(c, layer, tile_e));
            pg8::Gemm g{(const pg8::bf16_t*)WSP(unsigned char, WS_ACT), (const pg8::bf16_t*)(WSP(unsigned char, WS_W2) + (size_t)layer * 32 * 1024 * 1024), MPAD, 1024, 512};
            MoeOrder S{tile_e, nt, 2, c.G, vcu, nullptr, nullptr};
            EpiMoeOut E{WSP(unsigned char, WS_XP), a.in[I_B2] + (size_t)layer * 32 * 1024};
            pg8::gemm_phase<EpiMoeOut, MoeOrder, true, true, true>(c.lds, g, S, E);
        }
        SEAM(pb + 9);
    }
    if (DUP(13)) { for (int i = 0; i < 10; ++i) xcd_barrier(bar); }
    if (PT(12) && IN(22)) { phase_final(c, a); if (DUP(12)) { xcd_barrier(bar); phase_final(c, a); } }
#undef IN
#undef SEAM
}

#ifndef MK_CUTS
#define MK_CUTS 0
#endif
extern "C" void kernel_launch(void* const* d_in, const int* in_sizes, int n_in, void* d_out, int out_size, void* d_ws, size_t ws_size, hipStream_t stream) {
    static int grid = 0;
    if (grid == 0) {
        if (n_in != 25 || out_size != NLAT * D || ws_size < WS_END) { fprintf(stderr, "kernel_launch: unexpected shapes (n_in %d out %d ws %zu)\n", n_in, out_size, ws_size); grid = -1; return; }
        int dev = 0, cus = 0, per_cu = 0;
        if (hipGetDevice(&dev) != hipSuccess || hipDeviceGetAttribute(&cus, hipDeviceAttributeMultiprocessorCount, dev) != hipSuccess) { grid = -1; return; }
        if (hipFuncSetAttribute((const void*)fwd, hipFuncAttributeMaxDynamicSharedMemorySize, LDS_BYTES) != hipSuccess) { fprintf(stderr, "kernel_launch: hipFuncSetAttribute failed\n"); grid = -1; return; }
        if (hipOccupancyMaxActiveBlocksPerMultiprocessor(&per_cu, (const void*)fwd, NTHR, LDS_BYTES) != hipSuccess || per_cu < 1) { fprintf(stderr, "kernel_launch: occupancy query says %d\n", per_cu); }
        (void)hipGetLastError();
        grid = cus;
    }
    if (grid < 0) return;
    if (hipMemsetAsync((char*)d_ws + WS_CTL, 0, CTL_ZERO_BYTES, stream) != hipSuccess) return;
    Args a{};
    for (int i = 0; i < 25; ++i) a.in[i] = (const float*)d_in[i];
    a.out = (float*)d_out; a.ws = (unsigned char*)d_ws; a.pad = 0;
#if MK_CUTS == 0
    a.ph_lo = 0; a.ph_hi = NPHASES; a.li = 0;
    hipLaunchKernelGGL(fwd, dim3(grid), dim3(NTHR), LDS_BYTES, stream, a);
#else
    for (int p = 0; p < NPHASES; ++p) { a.ph_lo = p; a.ph_hi = p + 1; a.li = p; hipLaunchKernelGGL(fwd, dim3(grid), dim3(NTHR), LDS_BYTES, stream, a); }
#endif
}
```

```cpp
#include <hip/hip_runtime.h>
#include <cstdio>
#include <cstdint>
#ifndef DUP_MASK
#define DUP_MASK 0
#endif
#ifndef DUP6_SUB
#define DUP6_SUB 7
#endif
namespace pg8 {
#define PG8_LAS __attribute__((address_space(3)))
typedef unsigned short bf16_t;
typedef short bf16x8 __attribute__((ext_vector_type(8)));
typedef float f32x4 __attribute__((ext_vector_type(4)));
typedef unsigned u32x4 __attribute__((ext_vector_type(4)));
constexpr int BM = 256, BK = 64, HALF = 128, HTB = HALF * BK * 2  , STAGE_BYTES = 8 * HTB, NXCD = 8, WGM = 8;

__host__ __device__ __forceinline__ int lds_byte(int r, int c) { const int st = (r >> 4) * 2 + (c >> 5), rr = r & 15, cc = c & 31, ob = rr * 64 + cc * 2; return st * 1024 + (ob ^ (((ob >> 9) & 1) << 5)); }
__host__ __device__ __forceinline__ void stage_rc(int b, int& R, int& C) { const int st = b / 1024, sb = b % 1024, swz = sb ^ (((sb >> 9) & 1) << 5); R = (st >> 1) * 16 + swz / 64; C = (st & 1) * 32 + (swz % 64) / 2; }
__host__ __device__ __forceinline__ int perm32(int rho) { const int n = rho >> 4, i = rho & 15; return 8 * (i >> 2) + 4 * n + (i & 3); }

struct Unit { int pm, pn; };
struct Gemm { const bf16_t* A; const bf16_t* Bt; int M, N, K; };

struct StaticOrder {
    int nM, nN, nwg, G, c;
    __host__ __device__ void init(int M, int N, int G_, int c_) { nM = M / BM; nN = N / BM; nwg = nM * nN; G = G_; c = c_; }
    __host__ __device__ bool next(int i, Unit& u) const {
        const long L = (long)i * G + c; if (L >= nwg) return false;
        int wgid = (int)L; { const int q = nwg / NXCD, r = nwg % NXCD, xcd = wgid % NXCD, off = wgid / NXCD; wgid = (xcd < r ? xcd * (q + 1) : r * (q + 1) + (xcd - r) * q) + off; }
        const int nig = WGM * nN, gid = wgid / nig, fm = gid * WGM, gsz = (nM - fm) < WGM ? (nM - fm) : WGM;
        u.pm = fm + ((wgid % nig) % gsz); u.pn = (wgid % nig) / gsz; return true;
    }
    __device__ __forceinline__ void a_ready(const Unit&) const {}
    __device__ __forceinline__ void done(const Unit&) const {}
    __device__ __forceinline__ int arow(const Unit& u, int r) const { return u.pm * BM + r; }
};

__device__ __forceinline__ unsigned cvt_pk_bf16(float lo, float hi) { typedef __bf16 b2 __attribute__((ext_vector_type(2))); typedef float f2 __attribute__((ext_vector_type(2))); f2 v = {lo, hi}; return __builtin_bit_cast(unsigned, __builtin_convertvector(v, b2)); }
typedef int i32x8 __attribute__((ext_vector_type(8)));
typedef int i32x4v __attribute__((ext_vector_type(4)));
__device__ __forceinline__ i32x8 cat8(bf16x8 lo, bf16x8 hi) { return __builtin_shufflevector(__builtin_bit_cast(i32x4v, lo), __builtin_bit_cast(i32x4v, hi), 0, 1, 2, 3, 4, 5, 6, 7); }
__device__ __forceinline__ void mfma8_tied(f32x4& acc, i32x8 a, i32x8 b, int one) { asm volatile("v_mfma_scale_f32_16x16x128_f8f6f4 %0, %1, %2, %0, %3, %3 op_sel_hi:[0,0,0]" : "+v"(acc) : "v"(a), "v"(b), "v"(one)); }
template <class Epi, class Sched, bool ALIGN_EPI = false, bool SP2 = false, bool FP8 = false, bool GATHER = false>
__device__ __forceinline__ void gemm_phase(PG8_LAS unsigned char* lds, const Gemm g, const Sched& S, const Epi& E) {
    int tid_ = threadIdx.x; asm volatile("" : "+v"(tid_));
    const int tid = tid_, wid = __builtin_amdgcn_readfirstlane(tid >> 6), lane = tid & 63, wr = wid >> 2, wc = wid & 3, fr = lane & 15, fq = lane >> 4;
    const int K = g.K, nt = K / BK;
    int one8_ = 0x7f7f7f7f; asm volatile("" : "+v"(one8_));
    unsigned voffA[2], voffB[2];
#pragma unroll
    for (int i = 0; i < 2; ++i) { int R, C; stage_rc(tid * 16 + i * 8192, R, C); const int Rb = Epi::PERM ? ((R & ~31) + perm32(R & 31)) : R;
        voffA[i] = (unsigned)(R * K + C) * 2u; voffB[i] = (unsigned)(Rb * K + C) * 2u; }
    const size_t kstep = (size_t)(BK * 2);
    const size_t hstep = (size_t)HALF * K * 2;
    const size_t tstep = 2 * hstep;
    const unsigned ldsw = (unsigned)wid * 1024u;
    const int aoff = lds_byte(wr * 64 + fr, fq * 8), boff = lds_byte(wc * 32 + fr, fq * 8);
    unsigned va[2][2] = {{0u, 0u}, {0u, 0u}}, vn[2][2] = {{0u, 0u}, {0u, 0u}}; int tk[2][2] = {{0, 0}, {0, 0}};
#define PG8_AROWS(X, unit) do { if constexpr (GATHER) { int t3_ = threadIdx.x; asm volatile("" : "+v"(t3_)); _Pragma("unroll") for (int i_ = 0; i_ < 2; ++i_) { int R_, C_; stage_rc(t3_ * 16 + i_ * 8192, R_, C_); \
        _Pragma("unroll") for (int h_ = 0; h_ < 2; ++h_) X[h_][i_] = S.arow(unit, h_ * HALF + R_); } } } while (0)
#define PG8_AOFFS(X, T) do { if constexpr (GATHER) { int t3_ = threadIdx.x; asm volatile("" : "+v"(t3_)); _Pragma("unroll") for (int i_ = 0; i_ < 2; ++i_) { int R_, C_; stage_rc(t3_ * 16 + i_ * 8192, R_, C_); \
        _Pragma("unroll") for (int h_ = 0; h_ < 2; ++h_) X[h_][i_] = (unsigned)T[h_][i_] * (unsigned)(K * 2) + (unsigned)(C_ * 2); } } } while (0)
#define PG8_SA(b, h) (((b) * 2 + (h)) * HTB)
#define PG8_SB(b, h) ((4 + (b) * 2 + (h)) * HTB)
#ifndef PG8_BUF
#define PG8_BUF 1
#endif
#if PG8_BUF
    const __amdgpu_buffer_rsrc_t rsA = __builtin_amdgcn_make_buffer_rsrc((void*)g.A, 0, 0x7fffffff, 0x00020000), rsB = __builtin_amdgcn_make_buffer_rsrc((void*)g.Bt, 0, 0x7fffffff, 0x00020000);
#define PG8_STAGE(bufoff, gbase, voff) do { const bool isA_ = (bufoff) < 4 * HTB; const int so_ = (int)(unsigned)(size_t)((const char*)(gbase) - (const char*)(isA_ ? (const void*)g.A : (const void*)g.Bt)); \
        _Pragma("unroll") for (int _i = 0; _i < 2; ++_i) __builtin_amdgcn_raw_ptr_buffer_load_lds(isA_ ? rsA : rsB, (PG8_LAS void*)(lds + (bufoff) + ldsw + _i * 8192), 16, (int)(voff)[_i], so_, 0, 0); } while (0)
#else
#define PG8_STAGE(bufoff, gbase, voff) do { _Pragma("unroll") for (int _i = 0; _i < 2; ++_i) \
        __builtin_amdgcn_global_load_lds((const unsigned*)((const char*)(gbase) + (voff)[_i]), (PG8_LAS unsigned*)(lds + (bufoff) + ldsw + _i * 8192), 16, 0, 0); } while (0)
#endif
#define PG8_LDA(dst, b, h) do { _Pragma("unroll") for (int m = 0; m < 4; ++m) _Pragma("unroll") for (int k = 0; k < 2; ++k) dst[m][k] = *(const PG8_LAS bf16x8*)(lds + PG8_SA(b, h) + aoff + m * 2048 + k * 1024); } while (0)
#define PG8_LDB(dst, b, h) do { _Pragma("unroll") for (int n = 0; n < 2; ++n) _Pragma("unroll") for (int k = 0; k < 2; ++k) dst[n][k] = *(const PG8_LAS bf16x8*)(lds + PG8_SB(b, h) + boff + n * 2048 + k * 1024); } while (0)
#define PG8_MMA(ai, bj, At, Bt) do { __builtin_amdgcn_s_setprio(1); _Pragma("unroll") for (int m = 0; m < 4; ++m) _Pragma("unroll") for (int n = 0; n < 2; ++n) { \
        if constexpr (FP8) mfma8_tied(acc[ai][bj][m][n], cat8(Bt[n][0], Bt[n][1]), cat8(At[m][0], At[m][1]), one8_); \
        else { _Pragma("unroll") for (int k = 0; k < 2; ++k) acc[ai][bj][m][n] = __builtin_amdgcn_mfma_f32_16x16x32_bf16(Bt[n][k], At[m][k], acc[ai][bj][m][n], 0, 0, 0); } } __builtin_amdgcn_s_setprio(0); } while (0)
#define PG8_WAIT_V(n) asm volatile("s_waitcnt vmcnt(" #n ")" ::: "memory")
#define PG8_WAIT_L(n) asm volatile("s_waitcnt lgkmcnt(" #n ")" ::: "memory")
#define PG8_BAR __builtin_amdgcn_s_barrier()
#define PG8_SCHED __builtin_amdgcn_sched_barrier(0)
    Unit cur, nxt; int ui = 0;
    if (!S.next(0, cur)) return;
    f32x4 acc[2][2][4][2];
#pragma unroll
    for (int a = 0; a < 2; ++a)
#pragma unroll
        for (int b = 0; b < 2; ++b)
#pragma unroll
            for (int m = 0; m < 4; ++m)
#pragma unroll
                for (int n = 0; n < 2; ++n) acc[a][b][m][n] = (f32x4){0.f, 0.f, 0.f, 0.f};
    bf16x8 At[4][2], B0[2][2], B1[2][2];
    const char* cA = (const char*)g.A + (size_t)cur.pm * tstep; const char* cB = (const char*)g.Bt + (size_t)cur.pn * tstep;
    const char* const gA = (const char*)g.A;
    S.a_ready(cur);
    if constexpr (SP2) {
        if constexpr (GATHER) { PG8_AROWS(tk, cur); PG8_AOFFS(va, tk); }
        PG8_STAGE(PG8_SB(0, 0), cB, voffB); PG8_STAGE(PG8_SB(0, 1), cB + hstep, voffB);
        if constexpr (GATHER) { PG8_STAGE(PG8_SA(0, 0), gA, va[0]); PG8_STAGE(PG8_SA(0, 1), gA, va[1]); } else { PG8_STAGE(PG8_SA(0, 0), cA, voffA); PG8_STAGE(PG8_SA(0, 1), cA + hstep, voffA); }
        if (wr == 1) PG8_BAR;
        PG8_WAIT_V(2); PG8_BAR;
        PG8_STAGE(PG8_SB(1, 0), cB + kstep, voffB); if constexpr (GATHER) PG8_STAGE(PG8_SA(1, 0), gA + kstep, va[0]); else PG8_STAGE(PG8_SA(1, 0), cA + kstep, voffA); PG8_STAGE(PG8_SB(1, 1), cB + hstep + kstep, voffB);
        PG8_WAIT_V(6); PG8_BAR;
    } else {
        PG8_STAGE(PG8_SB(0, 0), cB, voffB); PG8_STAGE(PG8_SA(0, 0), cA, voffA); PG8_STAGE(PG8_SB(0, 1), cB + hstep, voffB); PG8_STAGE(PG8_SA(0, 1), cA + hstep, voffA);
        if (wr == 1) PG8_BAR;
        PG8_WAIT_V(4); PG8_BAR;
        PG8_STAGE(PG8_SB(1, 0), cB + kstep, voffB); PG8_STAGE(PG8_SA(1, 0), cA + kstep, voffA); PG8_STAGE(PG8_SB(1, 1), cB + hstep + kstep, voffB);
        PG8_WAIT_V(6); PG8_BAR;
    }
    for (;;) {
        const bool has_next = S.next(ui + 1, nxt);
        const char* nA = has_next ? (const char*)g.A + (size_t)nxt.pm * tstep : cA; const char* nB = has_next ? (const char*)g.Bt + (size_t)nxt.pn * tstep : cB;
#pragma nounroll
        for (int t = 0; t < nt; t += 2) {
            const bool last = (t == nt - 2);
            const char* a1 = cA + (size_t)(t + 1) * kstep;
            const char* a2 = last ? nA : cA + (size_t)(t + 2) * kstep; const char* b2 = last ? nB : cB + (size_t)(t + 2) * kstep;
            const char* a3 = a2 + kstep; const char* b3 = b2 + kstep;
            if (last && has_next) S.a_ready(nxt);
            if constexpr (GATHER) { if (t == 0 && has_next) PG8_AROWS(tk, nxt); if (last) { if (has_next) PG8_AOFFS(vn, tk); else { vn[0][0] = va[0][0]; vn[0][1] = va[0][1]; vn[1][0] = va[1][0]; vn[1][1] = va[1][1]; } } }
            const char* g1 = gA + (size_t)(t + 1) * kstep; const char* g2 = gA + (last ? 0 : (size_t)(t + 2) * kstep); const char* g3 = g2 + kstep;
            unsigned o0[2] = {last ? vn[0][0] : va[0][0], last ? vn[0][1] : va[0][1]}, o1[2] = {last ? vn[1][0] : va[1][0], last ? vn[1][1] : va[1][1]};
            if constexpr (SP2) {
            PG8_LDB(B0, 0, 0); PG8_LDB(B1, 0, 1); PG8_SCHED; PG8_LDA(At, 0, 0); if constexpr (GATHER) PG8_STAGE(PG8_SA(1, 1), g1, va[1]); else PG8_STAGE(PG8_SA(1, 1), a1 + hstep, voffA);
            PG8_WAIT_V(8); PG8_WAIT_L(0); PG8_BAR; PG8_MMA(0, 0, At, B0); PG8_MMA(0, 1, At, B1); PG8_BAR; PG8_SCHED;
            PG8_LDA(At, 0, 1); PG8_STAGE(PG8_SB(0, 0), b2, voffB); PG8_STAGE(PG8_SB(0, 1), b2 + hstep, voffB); if constexpr (GATHER) PG8_STAGE(PG8_SA(0, 0), g2, o0); else PG8_STAGE(PG8_SA(0, 0), a2, voffA);
            PG8_WAIT_V(8); PG8_WAIT_L(0); PG8_BAR; PG8_MMA(1, 0, At, B0); PG8_MMA(1, 1, At, B1); PG8_BAR; PG8_SCHED;
            PG8_LDB(B0, 1, 0); PG8_LDB(B1, 1, 1); PG8_SCHED; PG8_LDA(At, 1, 0); if constexpr (GATHER) PG8_STAGE(PG8_SA(0, 1), g2, o1); else PG8_STAGE(PG8_SA(0, 1), a2 + hstep, voffA);
            PG8_WAIT_V(8); PG8_WAIT_L(0); PG8_BAR; PG8_MMA(0, 0, At, B0); PG8_MMA(0, 1, At, B1); PG8_BAR; PG8_SCHED;
            PG8_LDA(At, 1, 1); PG8_STAGE(PG8_SB(1, 0), b3, voffB); PG8_STAGE(PG8_SB(1, 1), b3 + hstep, voffB); if constexpr (GATHER) PG8_STAGE(PG8_SA(1, 0), g3, o0); else PG8_STAGE(PG8_SA(1, 0), a3, voffA);
            PG8_WAIT_V(8); PG8_WAIT_L(0); PG8_BAR; PG8_MMA(1, 0, At, B0); PG8_MMA(1, 1, At, B1); PG8_BAR; PG8_SCHED;
            } else {
            PG8_LDB(B0, 0, 0); PG8_SCHED; PG8_LDA(At, 0, 0); PG8_STAGE(PG8_SA(1, 1), a1 + hstep, voffA);
            PG8_WAIT_L(8); PG8_BAR; PG8_WAIT_L(0); PG8_MMA(0, 0, At, B0); PG8_BAR; PG8_SCHED;
            PG8_LDB(B1, 0, 1); PG8_STAGE(PG8_SB(0, 0), b2, voffB);
            PG8_BAR; PG8_WAIT_L(0); PG8_MMA(0, 1, At, B1); PG8_BAR;
            PG8_LDA(At, 0, 1); PG8_STAGE(PG8_SA(0, 0), a2, voffA);
            PG8_BAR; PG8_WAIT_L(0); PG8_MMA(1, 0, At, B0); PG8_BAR; PG8_SCHED;
            PG8_STAGE(PG8_SB(0, 1), b2 + hstep, voffB);
            PG8_WAIT_V(6); PG8_BAR; PG8_MMA(1, 1, At, B1); PG8_BAR;
            PG8_LDB(B0, 1, 0); PG8_SCHED; PG8_LDA(At, 1, 0); PG8_STAGE(PG8_SA(0, 1), a2 + hstep, voffA);
            PG8_WAIT_L(8); PG8_BAR; PG8_WAIT_L(0); PG8_MMA(0, 0, At, B0); PG8_BAR; PG8_SCHED;
            PG8_LDB(B1, 1, 1); PG8_STAGE(PG8_SB(1, 0), b3, voffB);
            PG8_BAR; PG8_WAIT_L(0); PG8_MMA(0, 1, At, B1); PG8_BAR;
            PG8_LDA(At, 1, 1); PG8_STAGE(PG8_SA(1, 0), a3, voffA);
            PG8_BAR; PG8_WAIT_L(0); PG8_MMA(1, 0, At, B0); PG8_BAR; PG8_SCHED;
            PG8_STAGE(PG8_SB(1, 1), b3 + hstep, voffB);
            PG8_WAIT_V(6); PG8_BAR; PG8_MMA(1, 1, At, B1); PG8_BAR;
            }
        }
        if constexpr (ALIGN_EPI) { if (wr == 0) PG8_BAR; }
        if constexpr (!Epi::AFTER_DRAIN) { int t2_ = threadIdx.x; asm volatile("" : "+v"(t2_)); const int l2_ = t2_ & 63;
            E(acc, cur, wr, wc, l2_ & 15, l2_ >> 4); S.done(cur); }
        if (!has_next) break;
#pragma unroll
        for (int a = 0; a < 2; ++a)
#pragma unroll
            for (int b = 0; b < 2; ++b)
#pragma unroll
                for (int m = 0; m < 4; ++m)
#pragma unroll
                    for (int n = 0; n < 2; ++n) acc[a][b][m][n] = (f32x4){0.f, 0.f, 0.f, 0.f};
        cur = nxt; cA = nA; cB = nB; ++ui;
        if constexpr (GATHER) { va[0][0] = vn[0][0]; va[0][1] = vn[0][1]; va[1][0] = vn[1][0]; va[1][1] = vn[1][1]; }
        if constexpr (ALIGN_EPI) { if (wr == 1) PG8_BAR; }
    }
    PG8_WAIT_V(0);
    if constexpr (!ALIGN_EPI) { if (wr == 0) PG8_BAR; }
    PG8_BAR;
    if constexpr (Epi::AFTER_DRAIN) { E.fused(acc, cur, wr, wc, fr, fq, lds, wid, lane); S.done(cur); }
#undef PG8_SA
#undef PG8_AROWS
#undef PG8_AOFFS
#undef PG8_SB
#undef PG8_STAGE
#undef PG8_LDA
#undef PG8_LDB
#undef PG8_MMA
#undef PG8_WAIT_V
#undef PG8_WAIT_L
#undef PG8_BAR
#undef PG8_SCHED
}
}

constexpr int D = 1024, NB = 4, SEQ = 8192, CTXL = 256, NLAT = NB * SEQ, NCTX = NB * CTXL, NTOK = NLAT + NCTX, DEPTH = 2;
constexpr int NPROJ = 3584, NPAD = 3840, DIN = 3608;
constexpr int C_NAQ = 0, C_NAK = 512, C_NAV = 1024, C_XBC = 1536, C_Z = 2304, C_MLQ = 2560, C_MLK = 2816, C_MLV = 3072, C_MLO = 3328;
constexpr int NSC = 66;
constexpr int NEXP = 32;
constexpr int MPAD = 143360, MAXTILES = 560;
constexpr float EPS = 1e-6f, LOG2E = 1.4426950408889634f;
constexpr int NWAVES = 8, NTHR = 512;
constexpr int NPHASES = 23;
constexpr float W8_SCALE = 32.f, W8_INV = 1.f / 32.f;

constexpr size_t MiB = 1u << 20;
constexpr size_t WS_CTL = 0, CTL_ZERO_BYTES = 1 * MiB;
constexpr size_t WS_MOD = 1 * MiB, WS_ROPE = 2 * MiB, WS_WIN = 4 * MiB, WS_WOUT = 20 * MiB, WS_W1 = 24 * MiB, WS_W2 = 280 * MiB;
constexpr size_t WS_H = 408 * MiB, WS_U = 540 * MiB, WS_PROJ = 606 * MiB, WS_GATES = 837 * MiB, WS_SST = 842 * MiB, WS_MC = 908 * MiB, WS_MISC = 941 * MiB;
constexpr size_t WS_MIX = 943 * MiB, WS_XP = 1009 * MiB, WS_ACT = 1289 * MiB, WS_ROUTE = 1569 * MiB, WS_SSTB = 1573 * MiB, WS_MCB = 1607 * MiB, WS_END = 1624 * MiB;
constexpr size_t WS_RWT = 1 * MiB + 512 * 1024;
constexpr int NSIDX = NB * 2 * 4 * NSC;
constexpr int CW_BAR = 4096, CW_CNT = 131072;
constexpr int LDS_BYTES = 147456, MISC_OFF = 147200, LDS_TILE_OFF = 131072;

#define DI __device__ __forceinline__
#define LAS __attribute__((address_space(3)))
typedef unsigned short bf16;
typedef short bf16x8 __attribute__((ext_vector_type(8)));
typedef short s16x4 __attribute__((ext_vector_type(4)));
typedef float f32x4 __attribute__((ext_vector_type(4)));
typedef float f32x2 __attribute__((ext_vector_type(2)));
typedef unsigned u32x4 __attribute__((ext_vector_type(4)));
typedef unsigned u32x2 __attribute__((ext_vector_type(2)));

DI unsigned pk2(float lo, float hi) { typedef __bf16 b2 __attribute__((ext_vector_type(2))); f32x2 v = {lo, hi}; return __builtin_bit_cast(unsigned, __builtin_convertvector(v, b2)); }
DI unsigned pk4_fp8(float a, float b, float c2, float d) { int w = __builtin_amdgcn_cvt_pk_fp8_f32(a, b, 0, false); w = __builtin_amdgcn_cvt_pk_fp8_f32(c2, d, w, true); return (unsigned)w; }
DI f32x4 fp8x4_to_f32(unsigned w) { typedef float f2 __attribute__((ext_vector_type(2))); const f2 lo = __builtin_amdgcn_cvt_pk_f32_fp8((int)w, false), hi = __builtin_amdgcn_cvt_pk_f32_fp8((int)w, true); return (f32x4){lo.x, lo.y, hi.x, hi.y}; }
DI float bflo(unsigned u) { return __uint_as_float(u << 16); }
DI float bfhi(unsigned u) { return __uint_as_float(u & 0xffff0000u); }
DI float bf2f(unsigned short h) { return __uint_as_float(((unsigned)h) << 16); }
#define DPP_F(v, ctrl) __builtin_bit_cast(float, __builtin_amdgcn_update_dpp(0, __builtin_bit_cast(int, v), ctrl, 0xF, 0xF, false))
DI float rl_f(float v, int lane) { return __builtin_bit_cast(float, __builtin_amdgcn_readlane(__builtin_bit_cast(int, v), lane)); }
DI float wave_sum(float v) {
    v += DPP_F(v, 0xB1); v += DPP_F(v, 0x4E); v += DPP_F(v, 0x141); v += DPP_F(v, 0x140);
    return (rl_f(v, 0) + rl_f(v, 16)) + (rl_f(v, 32) + rl_f(v, 48));
}
DI float wave_max(float v) {
    v = fmaxf(v, DPP_F(v, 0xB1)); v = fmaxf(v, DPP_F(v, 0x4E)); v = fmaxf(v, DPP_F(v, 0x141)); v = fmaxf(v, DPP_F(v, 0x140));
    return fmaxf(fmaxf(rl_f(v, 0), rl_f(v, 16)), fmaxf(rl_f(v, 32), rl_f(v, 48)));
}
#define DPP_FI(v, ctrl, ident) __builtin_bit_cast(float, __builtin_amdgcn_update_dpp(__builtin_bit_cast(int, (float)(ident)), __builtin_bit_cast(int, v), ctrl, 0xF, 0xF, false))
DI float scan_add(float s, int lane) {
    s += DPP_FI(s, 0x111, 0.f); s += DPP_FI(s, 0x112, 0.f); s += DPP_FI(s, 0x114, 0.f); s += DPP_FI(s, 0x118, 0.f);
    const float t0 = rl_f(s, 15), t1 = rl_f(s, 31), t2 = rl_f(s, 47);
    return s + (lane >= 16 ? t0 : 0.f) + (lane >= 32 ? t1 : 0.f) + (lane >= 48 ? t2 : 0.f);
}
DI float scan_max(float s, int lane) {
    s = fmaxf(s, DPP_FI(s, 0x111, -INFINITY)); s = fmaxf(s, DPP_FI(s, 0x112, -INFINITY)); s = fmaxf(s, DPP_FI(s, 0x114, -INFINITY)); s = fmaxf(s, DPP_FI(s, 0x118, -INFINITY));
    const float t0 = rl_f(s, 15), t1 = rl_f(s, 31), t2 = rl_f(s, 47);
    return fmaxf(fmaxf(s, lane >= 16 ? t0 : -INFINITY), fmaxf(lane >= 32 ? t1 : -INFINITY, lane >= 48 ? t2 : -INFINITY));
}
DI void swap16(float& a, float& b) { asm volatile("s_nop 1\n\tv_permlane16_swap_b32 %0, %1" : "+v"(a), "+v"(b)); }
DI void swap16u(unsigned& a, unsigned& b) { asm volatile("s_nop 1\n\tv_permlane16_swap_b32 %0, %1" : "+v"(a), "+v"(b)); }
DI u32x4 widen16(u32x2 A, u32x2 B) { unsigned a0 = A.x, a1 = A.y, b0 = B.x, b1 = B.y; swap16u(a0, b0); swap16u(a1, b1); return (u32x4){a0, a1, b0, b1}; }
DI void swap32(float& a, float& b) { asm volatile("s_nop 1\n\tv_permlane32_swap_b32 %0, %1" : "+v"(a), "+v"(b)); }
DI float col4_sum(float v) { float a = v, b = v; swap16(a, b); v = a + b; a = v; b = v; swap32(a, b); return a + b; }
DI float col4_max(float v) { float a = v, b = v; swap16(a, b); v = fmaxf(a, b); a = v; b = v; swap32(a, b); return fmaxf(a, b); }
DI float sum8_dpp(float v) {
    v += __builtin_bit_cast(float, __builtin_amdgcn_update_dpp(0, __builtin_bit_cast(int, v), 0xB1, 0xF, 0xF, false));
    v += __builtin_bit_cast(float, __builtin_amdgcn_update_dpp(0, __builtin_bit_cast(int, v), 0x4E, 0xF, 0xF, false));
    v += __builtin_bit_cast(float, __builtin_amdgcn_update_dpp(0, __builtin_bit_cast(int, v), 0x141, 0xF, 0xF, false));
    return v;
}
DI float siluf(float x) { return x * __builtin_amdgcn_rcpf(1.f + __expf(-x)); }
DI float sigmf(float x) { return __builtin_amdgcn_rcpf(1.f + __expf(-x)); }
DI float softplusf(float x) { return fmaxf(x, 0.f) + __logf(1.f + __expf(-fabsf(x))); }
DI float logsigf(float x) { return fminf(x, 0.f) - __logf(1.f + __expf(-fabsf(x))); }
DI f32x4 mfma16(bf16x8 a, bf16x8 b, f32x4 c) { return __builtin_amdgcn_mfma_f32_16x16x32_bf16(a, b, c, 0, 0, 0); }
DI bf16x8 frag_kc(const LAS bf16* base, int ld, int r0, int k0, int lane) { return *(const LAS bf16x8*)(base + (r0 + (lane & 15)) * ld + k0 + 8 * (lane >> 4)); }
DI bf16x8 frag_tr(const LAS bf16* base, int ld, int k0, int c0, int lane) {
    const int i16 = lane & 15, q = i16 >> 2, p = i16 & 3, g = lane >> 4;
    const s16x4 lo = __builtin_amdgcn_ds_read_tr16_b64_v4i16((LAS s16x4*)(base + (k0 + 8 * g + q) * ld + c0 + 4 * p));
    const s16x4 hi = __builtin_amdgcn_ds_read_tr16_b64_v4i16((LAS s16x4*)(base + (k0 + 8 * g + 4 + q) * ld + c0 + 4 * p));
    return __builtin_shufflevector(lo, hi, 0, 1, 2, 3, 4, 5, 6, 7);
}
DI bf16x8 frag_trp(const LAS bf16* base, int ld, int k0, int c0, int lane) {
    const int i16 = lane & 15, q = i16 >> 2, p = i16 & 3, g = lane >> 4;
    const s16x4 lo = __builtin_amdgcn_ds_read_tr16_b64_v4i16((LAS s16x4*)(base + (k0 + 4 * g + q) * ld + c0 + 4 * p));
    const s16x4 hi = __builtin_amdgcn_ds_read_tr16_b64_v4i16((LAS s16x4*)(base + (k0 + 16 + 4 * g + q) * ld + c0 + 4 * p));
    return __builtin_shufflevector(lo, hi, 0, 1, 2, 3, 4, 5, 6, 7);
}
DI bf16x8 pack_acc(f32x4 a, f32x4 b) { u32x4 p; p.x = pk2(a.x, a.y); p.y = pk2(a.z, a.w); p.z = pk2(b.x, b.y); p.w = pk2(b.z, b.w); return __builtin_bit_cast(bf16x8, p); }
DI bf16x8 pack8(f32x4 a, f32x4 b) { return pack_acc(a, b); }
DI bf16x8 frag_gf32(const float* base, int ld, int r0, int k0, int lane) {
    const float* p = base + (size_t)(r0 + (lane & 15)) * ld + k0 + 8 * (lane >> 4);
    return pack8(*(const f32x4*)p, *(const f32x4*)(p + 4));
}
DI bf16x8 frag_gbf(const bf16* base, int ld, int r0, int k0, int lane) { return *(const bf16x8*)(base + (size_t)(r0 + (lane & 15)) * ld + k0 + 8 * (lane >> 4)); }
DI bf16x8 scale_frag(bf16x8 f, f32x4 w0, f32x4 w1) {
    const u32x4 u = __builtin_bit_cast(u32x4, f); u32x4 o;
    o.x = pk2(bflo(u.x) * w0.x, bfhi(u.x) * w0.y); o.y = pk2(bflo(u.y) * w0.z, bfhi(u.y) * w0.w);
    o.z = pk2(bflo(u.z) * w1.x, bfhi(u.z) * w1.y); o.w = pk2(bflo(u.w) * w1.z, bfhi(u.w) * w1.w);
    return __builtin_bit_cast(bf16x8, o);
}

struct Args { const float* in[25]; float* out; unsigned char* ws; int ph_lo, ph_hi, li, pad; };
enum { I_X = 0, I_C, I_CTX, I_CCTX, I_ADAW, I_ADAB, I_NORMG, I_WIN, I_QKG, I_RPB, I_CONVW, I_CONVB, I_DTB, I_ALOG, I_SSMD, I_SSMG, I_MLGB, I_MLG, I_WOUT, I_RW, I_RB, I_W1, I_B1, I_W2, I_B2 };

struct Ctx {
    LAS unsigned char* lds; int tid, lane, wave, G;
    unsigned char* ws;
};
#define WSP(T, off) ((T*)(c.ws + (off)))
DI void fresh_ctx(Ctx& c) { int t = threadIdx.x; asm volatile("" : "+v"(t)); c.tid = t; c.lane = t & 63; c.wave = __builtin_amdgcn_readfirstlane(t >> 6); }


DI void phase_ada(const Ctx& c, const Args& a) {
    LAS float* sc = (LAS float*)c.lds;
    LAS float* part = sc + 5 * 1024;
    float* mod = WSP(float, WS_MOD);
    for (int i = c.tid; i < 5 * 1024; i += NTHR) { const int r = i >> 10, k = i & 1023; const float x = r < 4 ? a.in[I_C][r * 1024 + k] : a.in[I_CCTX][k]; sc[i] = siluf(x); }
    __syncthreads();
    for (int item = blockIdx.x; item < 192; item += c.G) {
        const int l = item / 96, j0 = (item % 96) * 64, kl = c.lane >> 4, cq = c.lane & 15;
        const float* w = a.in[I_ADAW] + (size_t)l * 1024 * 6144 + j0 + 4 * cq;
        f32x4 acc[5];
#pragma unroll
        for (int r = 0; r < 5; ++r) acc[r] = (f32x4){0.f, 0.f, 0.f, 0.f};
#pragma unroll 8
        for (int kk = 0; kk < 32; ++kk) { const int k = c.wave * 128 + 4 * kk + kl; const f32x4 wv = __builtin_nontemporal_load((const f32x4*)(w + (size_t)k * 6144));
#pragma unroll
            for (int r = 0; r < 5; ++r) acc[r] += wv * sc[r * 1024 + k]; }
#pragma unroll
        for (int r = 0; r < 5; ++r) *(LAS f32x4*)(part + ((c.wave * 4 + kl) * 5 + r) * 64 + 4 * cq) = acc[r];
        __syncthreads();
        if (c.wave == 0) {
#pragma unroll
            for (int r = 0; r < 5; ++r) { float s = 0.f;
#pragma unroll 8
                for (int p = 0; p < 32; ++p) s += part[(p * 5 + r) * 64 + c.lane];
                mod[(l * 5 + r) * 6144 + j0 + c.lane] = s + a.in[I_ADAB][l * 6144 + j0 + c.lane]; }
        }
        __syncthreads();
    }
}

DI int src_col_win(int n) {
    if (n < 1024) { const int p = n & 255; return (n & ~255) + ((p >> 5) & 3) * 64 + (p >> 7) * 32 + (p & 31); }
    return n < 2560 ? n : (n < 3584 ? n + 8 : (n < 3592 ? n - 1024 : (n < 3608 ? n : -1))); }
DI void cvt_tile(const Ctx& c, const float* src, int ldsrc, bf16* dst, int n0, int k0, int mode) {
    LAS unsigned* t = (LAS unsigned*)c.lds;
    const int nq = c.tid & 15, kq = c.tid >> 4, n = n0 + 4 * nq;
    const int scol = mode == 0 ? src_col_win(n) : n;
    f32x4 v[4];
#pragma unroll
    for (int i = 0; i < 4; ++i) v[i] = scol >= 0 ? __builtin_nontemporal_load((const f32x4*)(src + (size_t)(k0 + 4 * kq + i) * ldsrc + scol)) : (f32x4){0.f, 0.f, 0.f, 0.f};
    LAS unsigned* p = t + (4 * nq) * 68 + 2 * kq;
    p[0] = pk2(v[0].x, v[1].x); p[1] = pk2(v[2].x, v[3].x); p[68] = pk2(v[0].y, v[1].y); p[69] = pk2(v[2].y, v[3].y);
    p[136] = pk2(v[0].z, v[1].z); p[137] = pk2(v[2].z, v[3].z); p[204] = pk2(v[0].w, v[1].w); p[205] = pk2(v[2].w, v[3].w);
    __syncthreads();
#pragma unroll
    for (int i = 0; i < 2; ++i) { const int idx = c.tid + NTHR * i, r = idx >> 4, ch = idx & 15;
        *(u32x4*)(dst + (size_t)(n0 + r) * 1024 + k0 + 8 * ch) = *(const LAS u32x4*)(t + r * 68 + 4 * ch); }
    __syncthreads();
}
struct Cvt8Tile { const float* src; unsigned char* dst; int ldsrc, n0, k0, mode; };
DI Cvt8Tile cvt8_decode(const Args& a, unsigned char* w1d, unsigned char* w2d, int r) {
    Cvt8Tile t;
    if (r < 64 * 128) { const int m = r >> 7, q = r & 127; t.src = a.in[I_W1] + (size_t)m * 1024 * 2048; t.ldsrc = 2048; t.dst = w1d + (size_t)m * 2048 * 1024; t.n0 = (q >> 3) * 128; t.k0 = (q & 7) * 128; t.mode = 2; }
    else { r -= 64 * 128; const int m = r >> 6, q = r & 63; t.src = a.in[I_W2] + (size_t)m * 1024 * 1024; t.ldsrc = 1024; t.dst = w2d + (size_t)m * 1024 * 1024; t.n0 = (q >> 3) * 128; t.k0 = (q & 7) * 128; t.mode = 1; }
    return t;
}
DI void cvt8_load(const Ctx& c, const Cvt8Tile& t, f32x4 (&v)[8]) {
    const int nq = c.tid & 31, kq = c.tid >> 5, n = t.n0 + 4 * nq;
    const int scol = t.mode == 1 ? n : (((n & 255) < 128 ? 0 : 1024) + (n >> 8) * 128 + (n & 127));
#pragma unroll
    for (int i = 0; i < 8; ++i) v[i] = __builtin_nontemporal_load((const f32x4*)(t.src + (size_t)(t.k0 + 8 * kq + i) * t.ldsrc + scol));
}
DI void cvt8_store(const Ctx& c, const Cvt8Tile& t, const f32x4 (&v)[8]) {
    LAS unsigned* tl = (LAS unsigned*)c.lds;
    const int nq = c.tid & 31, kq = c.tid >> 5;
#pragma unroll
    for (int hq = 0; hq < 2; ++hq) { LAS unsigned* p = tl + (2 * kq + hq) * 129 + 4 * nq;
        p[0] = pk4_fp8(v[4 * hq].x * W8_SCALE, v[4 * hq + 1].x * W8_SCALE, v[4 * hq + 2].x * W8_SCALE, v[4 * hq + 3].x * W8_SCALE);
        p[1] = pk4_fp8(v[4 * hq].y * W8_SCALE, v[4 * hq + 1].y * W8_SCALE, v[4 * hq + 2].y * W8_SCALE, v[4 * hq + 3].y * W8_SCALE);
        p[2] = pk4_fp8(v[4 * hq].z * W8_SCALE, v[4 * hq + 1].z * W8_SCALE, v[4 * hq + 2].z * W8_SCALE, v[4 * hq + 3].z * W8_SCALE);
        p[3] = pk4_fp8(v[4 * hq].w * W8_SCALE, v[4 * hq + 1].w * W8_SCALE, v[4 * hq + 2].w * W8_SCALE, v[4 * hq + 3].w * W8_SCALE); }
    __syncthreads();
    { const int r = c.tid >> 2, ch = c.tid & 3;
#pragma unroll
      for (int hq = 0; hq < 2; ++hq) { const int cc = ch + 4 * hq; u32x4 o; o.x = tl[(4 * cc + 0) * 129 + r]; o.y = tl[(4 * cc + 1) * 129 + r]; o.z = tl[(4 * cc + 2) * 129 + r]; o.w = tl[(4 * cc + 3) * 129 + r];
          *(u32x4*)(t.dst + (size_t)(t.n0 + r) * 1024 + t.k0 + 16 * cc) = o; } }
    __syncthreads();
}
DI void phase_convert(const Ctx& c, const Args& a) {
    constexpr int T_WIN = 2 * 60 * 8, T_WOUT = 2 * 16 * 8, T_W8 = 64 * 128 + 64 * 64;
    for (int it = blockIdx.x; it < T_WIN + T_WOUT; it += c.G) {
        int r = it;
        if (r < T_WIN) { const int l = r / 480; r %= 480; cvt_tile(c, a.in[I_WIN] + (size_t)l * 1024 * DIN, DIN, WSP(bf16, WS_WIN) + (size_t)l * NPAD * 1024, (r >> 3) * 64, (r & 7) * 128, 0); continue; }
        r -= T_WIN;
        { const int l = r / 128; r %= 128; cvt_tile(c, a.in[I_WOUT] + (size_t)l * 1024 * 1024, 1024, WSP(bf16, WS_WOUT) + (size_t)l * 1024 * 1024, (r >> 3) * 64, (r & 7) * 128, 1); }
    }
    {
        unsigned char* w1d = WSP(unsigned char, WS_W1); unsigned char* w2d = WSP(unsigned char, WS_W2);
        int it = blockIdx.x; f32x4 v[8];
        Cvt8Tile t = cvt8_decode(a, w1d, w2d, it < T_W8 ? it : 0);
        if (it < T_W8) cvt8_load(c, t, v);
        while (it < T_W8) {
            const int nx = it + c.G; f32x4 vn[8]; Cvt8Tile tn = cvt8_decode(a, w1d, w2d, nx < T_W8 ? nx : 0);
            if (nx < T_W8) cvt8_load(c, tn, vn);
            else {
#pragma unroll
                for (int i = 0; i < 8; ++i) vn[i] = v[i]; }
            cvt8_store(c, t, v);
#pragma unroll
            for (int i = 0; i < 8; ++i) v[i] = vn[i];
            t = tn; it = nx;
        }
    }
    for (int idx = blockIdx.x * NTHR + c.tid; idx < 2 * 32 * 1024; idx += c.G * NTHR) {
        const int l = idx >> 15, e = (idx >> 10) & 31, k = idx & 1023; const float w = a.in[I_RW][((size_t)l * 1024 + k) * 32 + e];
        const unsigned hi = pk2(w, 0.f) & 0xffffu; const unsigned lo = pk2(w - bflo(hi), 0.f) & 0xffffu;
        bf16* rwt = WSP(bf16, WS_RWT) + (size_t)l * 2 * 32 * 1024; rwt[e * 1024 + k] = (bf16)hi; rwt[32 * 1024 + e * 1024 + k] = (bf16)lo; }
    float* rc = WSP(float, WS_ROPE); float* rs = rc + 8192 * 32;
    for (int idx = blockIdx.x * NTHR + c.tid; idx < 8192 * 32; idx += c.G * NTHR) {
        const int pos = idx >> 5, f = idx & 31, row = pos >> 6, col = pos & 63;
        const float inv = exp2f(-(float)(f & 15) * (13.287712379549449f / 16.f));
        const float ang = (float)(f < 16 ? row : col) * inv;
        const float k = rintf(ang * 0.15915494309189535f);
        float rr = fmaf(-k, 6.28318548202514648f, ang); rr = fmaf(-k, -1.7484555e-7f, rr);
        rc[idx] = cosf(rr); rs[idx] = sinf(rr);
    }
}

DI void build_pbase(const Ctx& c, int layer, LAS int* pbase) {
    const unsigned* cnt = WSP(unsigned, WS_CTL) + CW_CNT + layer * 32;
    if (c.tid == 0) { int s = 0; for (int e = 0; e < 32; ++e) { pbase[e] = s; s += ((int)cnt[e] + 255) & ~255; } pbase[32] = s; }
    __syncthreads();
}
struct Route { int e[4], s[4]; float w[4]; };
DI void route_load(const Ctx& c, int row, Route& r) {
    const int* tok_e = WSP(int, WS_ROUTE); const int* tok_slot = tok_e + NTOK * 4; const float* tok_w = (const float*)(tok_slot + NTOK * 4);
    typedef int i4 __attribute__((ext_vector_type(4)));
    const i4 e = *(const i4*)(tok_e + row * 4), s = *(const i4*)(tok_slot + row * 4); const f32x4 w = *(const f32x4*)(tok_w + row * 4);
    r.e[0] = e.x; r.e[1] = e.y; r.e[2] = e.z; r.e[3] = e.w; r.s[0] = s.x; r.s[1] = s.y; r.s[2] = s.z; r.s[3] = s.w; r.w[0] = w.x; r.w[1] = w.y; r.w[2] = w.z; r.w[3] = w.w;
}
template <bool LAST> DI void comb_issue(const Ctx& c, const LAS int* pbase, const Route& r, int row, unsigned (&y)[4][4], u32x2 (&h)[4]) {
    const unsigned char* Y = WSP(unsigned char, WS_XP); const bf16* H = WSP(bf16, WS_H);
#pragma unroll
    for (int k = 0; k < 4; ++k) { const int prow = pbase[r.e[k]] + r.s[k];
#pragma unroll
        for (int j = 0; j < 4; ++j) { const unsigned* p = (const unsigned*)(Y + (size_t)prow * 1024 + 4 * (c.lane + 64 * j)); y[k][j] = __builtin_nontemporal_load(p); } }
#pragma unroll
    for (int j = 0; j < 4; ++j) { const u32x2* p = (const u32x2*)(H + (size_t)row * 1024 + 4 * (c.lane + 64 * j)); h[j] = LAST ? __builtin_nontemporal_load(p) : *p; }
}
DI void comb_reduce(const Ctx& c, const Route& r, const unsigned (&y)[4][4], const u32x2 (&h)[4], const f32x4 (&g2)[4], f32x4 (&v)[4]) {
#pragma unroll
    for (int j = 0; j < 4; ++j) { f32x4 s = fp8x4_to_f32(y[0][j]) * r.w[0]; s += fp8x4_to_f32(y[1][j]) * r.w[1]; s += fp8x4_to_f32(y[2][j]) * r.w[2]; s += fp8x4_to_f32(y[3][j]) * r.w[3];
        v[j] = (f32x4){bflo(h[j].x), bfhi(h[j].x), bflo(h[j].y), bfhi(h[j].y)} + g2[j] * s; }
}
#define COMB_PIPE_BEGIN(NROWS, LAST) \
    const int stride_ = c.G * NWAVES; int row = blockIdx.x * NWAVES + c.wave; \
    Route r0, r1, r2, r3; unsigned yc[4][4], yn[4][4], ym[4][4]; u32x2 hc[4], hn[4], hm[4]; \
    if (row < (NROWS)) { route_load(c, row, r0); comb_issue<LAST>(c, pbase, r0, row, yc, hc); } \
    if (row + stride_ < (NROWS)) { route_load(c, row + stride_, r1); comb_issue<LAST>(c, pbase, r1, row + stride_, yn, hn); } \
    if (row + 2 * stride_ < (NROWS)) route_load(c, row + 2 * stride_, r2); \
    for (; row < (NROWS); row += stride_) { \
        if (row + 2 * stride_ < (NROWS)) comb_issue<LAST>(c, pbase, r2, row + 2 * stride_, ym, hm); \
        if (row + 3 * stride_ < (NROWS)) route_load(c, row + 3 * stride_, r3);
#define COMB_PIPE_END() \
        r0 = r1; r1 = r2; r2 = r3; \
        _Pragma("unroll") for (int k_ = 0; k_ < 4; ++k_) { _Pragma("unroll") for (int j_ = 0; j_ < 4; ++j_) { yc[k_][j_] = yn[k_][j_]; yn[k_][j_] = ym[k_][j_]; } } \
        _Pragma("unroll") for (int j_ = 0; j_ < 4; ++j_) { hc[j_] = hn[j_]; hn[j_] = hm[j_]; } }
DI void vec4_load(const Ctx& c, const float* p, f32x4 (&d)[4]) {
#pragma unroll
    for (int j = 0; j < 4; ++j) d[j] = *(const f32x4*)(p + 4 * (c.lane + 64 * j)); }
DI void norm_store_u(const Ctx& c, const f32x4 (&ng)[4], const f32x4 (&sh)[4], const f32x4 (&sc1)[4], f32x4 (&v)[4], bf16* urow) {
    float ss = 0.f;
#pragma unroll
    for (int j = 0; j < 4; ++j) ss += (v[j].x * v[j].x + v[j].y * v[j].y) + (v[j].z * v[j].z + v[j].w * v[j].w);
    const float rstd = rsqrtf(wave_sum(ss) * (1.f / 1024.f) + EPS);
#pragma unroll
    for (int j = 0; j < 4; ++j) { const int col = 4 * (c.lane + 64 * j);
        const f32x4 o = (v[j] * rstd * ng[j]) * sc1[j] + sh[j];
        u32x2 w; w.x = pk2(o.x, o.y); w.y = pk2(o.z, o.w); *(u32x2*)(urow + col) = w; }
}
DI void phase_norm1(const Ctx& c, const Args& a, int layer) {
    const float* mod = WSP(float, WS_MOD); bf16* H = WSP(bf16, WS_H); bf16* U = WSP(bf16, WS_U);
    const float* ng = a.in[I_NORMG] + (layer * 2 + 0) * 1024;
    LAS int* pbase = (LAS int*)c.lds;
    f32x4 cng[4], csh[4], csc[4]; vec4_load(c, ng, cng); int rprev = -1;
    if (layer == 0) {
        const int stride = c.G * NWAVES; int row = blockIdx.x * NWAVES + c.wave;
        f32x4 vq[4];
        if (row < NTOK) { const float* s0 = row < NLAT ? a.in[I_X] + (size_t)row * 1024 : a.in[I_CTX] + (size_t)(row - NLAT) * 1024;
#pragma unroll
            for (int j = 0; j < 4; ++j) vq[j] = __builtin_nontemporal_load((const f32x4*)(s0 + 4 * (c.lane + 64 * j))); }
        for (; row < NTOK; row += stride) {
            const int r = row < NLAT ? row >> 13 : 4;
            if (r != rprev) { rprev = r; const float* m = mod + (layer * 5 + r) * 6144; vec4_load(c, m, csh); vec4_load(c, m + 1024, csc);
#pragma unroll
                for (int j = 0; j < 4; ++j) csc[j] += 1.f; }
            f32x4 v[4];
#pragma unroll
            for (int j = 0; j < 4; ++j) v[j] = vq[j];
            { const int nr = row + stride; if (nr < NTOK) { const float* src = nr < NLAT ? a.in[I_X] + (size_t)nr * 1024 : a.in[I_CTX] + (size_t)(nr - NLAT) * 1024;
#pragma unroll
                for (int j = 0; j < 4; ++j) vq[j] = __builtin_nontemporal_load((const f32x4*)(src + 4 * (c.lane + 64 * j))); } }
            norm_store_u(c, cng, csh, csc, v, U + (size_t)row * 1024);
        }
    } else {
        f32x4 cg2[4];
        build_pbase(c, layer - 1, pbase);
        COMB_PIPE_BEGIN(NTOK, false)
            const int r = row < NLAT ? row >> 13 : 4;
            if (r != rprev) { rprev = r; const float* m = mod + (layer * 5 + r) * 6144; vec4_load(c, m, csh); vec4_load(c, m + 1024, csc); vec4_load(c, mod + ((layer - 1) * 5 + r) * 6144 + 5 * 1024, cg2);
#pragma unroll
                for (int j = 0; j < 4; ++j) csc[j] += 1.f; }
            f32x4 v[4]; comb_reduce(c, r0, yc, hc, cg2, v);
#pragma unroll
            for (int j = 0; j < 4; ++j) { u32x2 hw; hw.x = pk2(v[j].x, v[j].y); hw.y = pk2(v[j].z, v[j].w); *(u32x2*)(H + (size_t)row * 1024 + 4 * (c.lane + 64 * j)) = hw; }
            norm_store_u(c, cng, csh, csc, v, U + (size_t)row * 1024);
        COMB_PIPE_END()
    }
    __syncthreads();
}

struct EpiProj {
    static constexpr bool PERM = true, AFTER_DRAIN = false;
    bf16* P; float* Gt; const float* qkg;
    __device__ __forceinline__ void operator()(const pg8::f32x4 (&acc)[2][2][4][2], const pg8::Unit& u, int wr, int wc, int fr, int fq) const {
        const int row0 = u.pm * 256 + wr * 64 + fr;
        if (u.pn < 4) {
            const float* g = qkg + (u.pn >> 1) * 64 + 8 * fq; const float qs = u.pn < 2 ? 0.125f * LOG2E : 1.f;
            const pg8::f32x4 g0 = *(const pg8::f32x4*)g * qs, g1 = *(const pg8::f32x4*)(g + 4) * qs, g2 = *(const pg8::f32x4*)(g + 32) * qs, g3 = *(const pg8::f32x4*)(g + 36) * qs;
            const int col0 = u.pn * 256 + wc * 64 + 8 * fq;
#pragma unroll
            for (int ai = 0; ai < 2; ++ai)
#pragma unroll
                for (int m = 0; m < 4; ++m) {
                    const pg8::f32x4 a0 = acc[ai][0][m][0], a1 = acc[ai][0][m][1], b0 = acc[ai][1][m][0], b1 = acc[ai][1][m][1];
                    float ss = (a0[0] * a0[0] + a0[1] * a0[1]) + (a0[2] * a0[2] + a0[3] * a0[3]) + (a1[0] * a1[0] + a1[1] * a1[1]) + (a1[2] * a1[2] + a1[3] * a1[3])
                             + (b0[0] * b0[0] + b0[1] * b0[1]) + (b0[2] * b0[2] + b0[3] * b0[3]) + (b1[0] * b1[0] + b1[1] * b1[1]) + (b1[2] * b1[2] + b1[3] * b1[3]);
                    ss = col4_sum(ss);
                    const float rstd = __builtin_amdgcn_rsqf(ss * (1.f / 64.f) + EPS);
                    const pg8::f32x4 o0 = a0 * g0 * rstd, o1 = a1 * g1 * rstd, o2 = b0 * g2 * rstd, o3 = b1 * g3 * rstd;
                    bf16* rowp = P + (size_t)(row0 + ai * 128 + m * 16) * NPROJ + col0;
                    u32x4 w; w.x = pk2(o0[0], o0[1]); w.y = pk2(o0[2], o0[3]); w.z = pk2(o1[0], o1[1]); w.w = pk2(o1[2], o1[3]); *(u32x4*)rowp = w;
                    w.x = pk2(o2[0], o2[1]); w.y = pk2(o2[2], o2[3]); w.z = pk2(o3[0], o3[1]); w.w = pk2(o3[2], o3[3]); *(u32x4*)(rowp + 32) = w; }
        } else if (u.pn < 14) {
            const int col0 = u.pn * 256 + wc * 32 + 8 * fq;
#pragma unroll
            for (int ai = 0; ai < 2; ++ai)
#pragma unroll
                for (int m = 0; m < 4; ++m) { bf16* rowp = P + (size_t)(row0 + ai * 128 + m * 16) * NPROJ + col0;
#pragma unroll
                    for (int bj = 0; bj < 2; ++bj) { const pg8::f32x4 v0 = acc[ai][bj][m][0], v1 = acc[ai][bj][m][1];
                        u32x4 w; w.x = pk2(v0[0], v0[1]); w.y = pk2(v0[2], v0[3]); w.z = pk2(v1[0], v1[1]); w.w = pk2(v1[2], v1[3]);
                        *(u32x4*)(rowp + bj * 128) = w; } }
        } else if (wc == 0 && fq < 3) {
#pragma unroll
            for (int ai = 0; ai < 2; ++ai)
#pragma unroll
                for (int m = 0; m < 4; ++m) { float* gp = Gt + (size_t)(8 * fq) * NTOK + (row0 + ai * 128 + m * 16);
#pragma unroll
                    for (int n = 0; n < 2; ++n)
#pragma unroll
                        for (int q = 0; q < 4; ++q) gp[(size_t)(4 * n + q) * NTOK] = acc[ai][0][m][n][q]; }
        }
    }
};
struct EpiRes {
    static constexpr bool PERM = true, AFTER_DRAIN = false;
    bf16* H; const float* g1; const float* srcl; const float* srcc; int from_h;
    __device__ __forceinline__ void operator()(const pg8::f32x4 (&acc)[2][2][4][2], const pg8::Unit& u, int wr, int wc, int fr, int fq) const {
        const int row0 = u.pm * 256 + wr * 64 + fr, col0 = u.pn * 256 + wc * 32 + 8 * fq;
        const float* g = g1 + (u.pm < 128 ? (u.pm >> 5) : 4) * 6144;
        pg8::f32x4 gv[2][2];
#pragma unroll
        for (int bj = 0; bj < 2; ++bj)
#pragma unroll
            for (int n = 0; n < 2; ++n) gv[bj][n] = *(const pg8::f32x4*)(g + col0 + bj * 128 + 4 * n);
#pragma unroll
        for (int ai = 0; ai < 2; ++ai)
#pragma unroll
            for (int m = 0; m < 4; ++m) { const int rr = row0 + ai * 128 + m * 16; bf16* rowp = H + (size_t)rr * 1024 + col0;
                const float* sp = (u.pm < 128 ? srcl + (size_t)rr * 1024 : srcc + (size_t)(rr - NLAT) * 1024) + col0;
#pragma unroll
                for (int bj = 0; bj < 2; ++bj) { pg8::f32x4 r0, r1;
                    if (from_h) { const u32x4 hv = *(const u32x4*)(rowp + bj * 128); r0 = (pg8::f32x4){bflo(hv.x), bfhi(hv.x), bflo(hv.y), bfhi(hv.y)}; r1 = (pg8::f32x4){bflo(hv.z), bfhi(hv.z), bflo(hv.w), bfhi(hv.w)}; }
                    else { r0 = *(const pg8::f32x4*)(sp + bj * 128); r1 = *(const pg8::f32x4*)(sp + bj * 128 + 4); }
                    const pg8::f32x4 o0 = r0 + gv[bj][0] * acc[ai][bj][m][0], o1 = r1 + gv[bj][1] * acc[ai][bj][m][1];
                    u32x4 w; w.x = pk2(o0[0], o0[1]); w.y = pk2(o0[2], o0[3]); w.z = pk2(o1[0], o1[1]); w.w = pk2(o1[2], o1[3]);
                    *(u32x4*)(rowp + bj * 128) = w; } }
    }
};
struct EpiSwiglu {
    static constexpr bool PERM = true, AFTER_DRAIN = false;
    unsigned char* A2; const float* b1;
    __device__ __forceinline__ void operator()(const pg8::f32x4 (&acc)[2][2][4][2], const pg8::Unit& u, int wr, int wc, int fr, int fq) const {
        const int e = u.pn >> 3, pn = u.pn & 7, row0 = u.pm * 256 + wr * 64 + fr, j0 = pn * 128 + wc * 32 + 8 * fq;
        const float* bg = b1 + e * 2048 + j0; const float* bl = bg + 1024;
        typedef float f2v __attribute__((ext_vector_type(2)));
        const pg8::f32x4 bg0 = *(const pg8::f32x4*)bg, bg1 = *(const pg8::f32x4*)(bg + 4), bl0 = *(const pg8::f32x4*)bl + 1.f, bl1 = *(const pg8::f32x4*)(bl + 4) + 1.f;
        const f2v sc = {W8_INV, W8_INV}, ne = {-1.702f * LOG2E, -1.702f * LOG2E}, one = {1.f, 1.f};
        const int sel = fq & 1; unsigned char* base = A2 + (size_t)(row0 + sel * 16) * 1024 + (j0 - 8 * sel);
#pragma unroll
        for (int ai = 0; ai < 2; ++ai)
#pragma unroll
            for (int p = 0; p < 2; ++p) {
                unsigned wv[2][2];
#pragma unroll
                for (int mm = 0; mm < 2; ++mm) { const int m = 2 * p + mm;
                    f2v o[4];
#pragma unroll
                    for (int n = 0; n < 2; ++n) {
                        const pg8::f32x4 ag = acc[ai][0][m][n], al = acc[ai][1][m][n], vbg = n ? bg1 : bg0, vbl = n ? bl1 : bl0;
#pragma unroll
                        for (int h = 0; h < 2; ++h) {
                            f2v g = (h ? __builtin_shufflevector(ag, ag, 2, 3) : __builtin_shufflevector(ag, ag, 0, 1)) * sc + (h ? __builtin_shufflevector(vbg, vbg, 2, 3) : __builtin_shufflevector(vbg, vbg, 0, 1));
                            f2v l = (h ? __builtin_shufflevector(al, al, 2, 3) : __builtin_shufflevector(al, al, 0, 1)) * sc + (h ? __builtin_shufflevector(vbl, vbl, 2, 3) : __builtin_shufflevector(vbl, vbl, 0, 1));
                            g.x = fminf(g.x, 7.f); g.y = fminf(g.y, 7.f);
                            l.x = __builtin_amdgcn_fmed3f(l.x, -6.f, 8.f); l.y = __builtin_amdgcn_fmed3f(l.y, -6.f, 8.f);
                            const f2v t = g * ne; f2v d = {__builtin_amdgcn_exp2f(t.x), __builtin_amdgcn_exp2f(t.y)}; d = d + one;
                            const f2v r = {__builtin_amdgcn_rcpf(d.x), __builtin_amdgcn_rcpf(d.y)};
                            o[n * 2 + h] = (g * l) * r; } }
                    wv[mm][0] = pk4_fp8(o[0].x, o[0].y, o[1].x, o[1].y); wv[mm][1] = pk4_fp8(o[2].x, o[2].y, o[3].x, o[3].y); }
                swap16u(wv[0][0], wv[1][0]); swap16u(wv[0][1], wv[1][1]);
                u32x4 w; w.x = wv[0][0]; w.y = wv[0][1]; w.z = wv[1][0]; w.w = wv[1][1];
                *(u32x4*)(base + (size_t)(ai * 128 + p * 32) * 1024) = w; }
    }
};
struct EpiMoeOut {
    static constexpr bool PERM = true, AFTER_DRAIN = false;
    unsigned char* Y; const float* b2;
    __device__ __forceinline__ void operator()(const pg8::f32x4 (&acc)[2][2][4][2], const pg8::Unit& u, int wr, int wc, int fr, int fq) const {
        const int e = u.pn >> 2, pn = u.pn & 3, row0 = u.pm * 256 + wr * 64 + fr, col0 = pn * 256 + wc * 32 + 8 * fq;
        pg8::f32x4 bv[2][2];
#pragma unroll
        for (int bj = 0; bj < 2; ++bj)
#pragma unroll
            for (int n = 0; n < 2; ++n) bv[bj][n] = *(const pg8::f32x4*)(b2 + e * 1024 + col0 + bj * 128 + 4 * n);
        const int sel = fq & 1; unsigned char* base = Y + (size_t)(row0 + sel * 16) * 1024 + (col0 - 8 * sel);
#pragma unroll
        for (int ai = 0; ai < 2; ++ai)
#pragma unroll
            for (int p = 0; p < 2; ++p)
#pragma unroll
                for (int bj = 0; bj < 2; ++bj) {
                    const pg8::f32x4 a0 = acc[ai][bj][2 * p][0] * W8_INV + bv[bj][0], a1 = acc[ai][bj][2 * p][1] * W8_INV + bv[bj][1];
                    const pg8::f32x4 c0 = acc[ai][bj][2 * p + 1][0] * W8_INV + bv[bj][0], c1 = acc[ai][bj][2 * p + 1][1] * W8_INV + bv[bj][1];
                    unsigned x0 = pk4_fp8(a0[0], a0[1], a0[2], a0[3]), x1 = pk4_fp8(a1[0], a1[1], a1[2], a1[3]), y0 = pk4_fp8(c0[0], c0[1], c0[2], c0[3]), y1 = pk4_fp8(c1[0], c1[1], c1[2], c1[3]);
                    swap16u(x0, y0); swap16u(x1, y1);
                    u32x4 w; w.x = x0; w.y = x1; w.z = y0; w.w = y1;
                    *(u32x4*)(base + (size_t)(ai * 128 + p * 32) * 1024 + bj * 128) = w; }
    }
};
constexpr int ECAP = NTOK;
struct OneUnit {
    int pm, pn;
    __device__ __forceinline__ bool next(int i, pg8::Unit& u) const { if (i) return false; u.pm = pm; u.pn = pn; return true; }
    __device__ __forceinline__ void a_ready(const pg8::Unit&) const {}
    __device__ __forceinline__ void done(const pg8::Unit&) const {}
    __device__ __forceinline__ int arow(const pg8::Unit& u, int r) const { return u.pm * 256 + r; }
};
struct MoeOrder {
    const LAS int* tile_e; int ntiles, ntshift, G, cc; const int* etok; const unsigned* cnt;
    __device__ __forceinline__ bool next(int i, pg8::Unit& u) const {
        const int L = i * G + cc; if (L >= (ntiles << ntshift)) return false;
        const int pm = L >> ntshift; u.pm = pm; u.pn = (__builtin_amdgcn_readfirstlane(tile_e[pm]) << ntshift) + (L & ((1 << ntshift) - 1)); return true; }
    __device__ __forceinline__ void a_ready(const pg8::Unit&) const {}
    __device__ __forceinline__ void done(const pg8::Unit&) const {}
    __device__ __forceinline__ int arow(const pg8::Unit& u, int r) const {
        const int e = u.pn >> ntshift, slot = tile_e[MAXTILES + u.pm] + r; return slot < (int)cnt[e] ? etok[(size_t)e * ECAP + slot] : 0; }
};
#define XB_TMO      128
#define XB_XCNT(j)  (256  + 64 * (j))
#define XB_XSUB(j)  (1280 + 64 * (j))
#define XB_XGEN(j)  (2304 + 64 * (j))
#define XB_TOP      3328
#define XB_TOPGEN   3392
#define XCD_BAR_WORDS 3456
#define XB_SPIN_CAP (1u << 18)

__device__ __forceinline__ unsigned xb_ld(unsigned* p)              { return __hip_atomic_load(p, __ATOMIC_RELAXED, __HIP_MEMORY_SCOPE_AGENT); }
__device__ __forceinline__ unsigned xb_add(unsigned* p, unsigned v) { return __hip_atomic_fetch_add(p, v, __ATOMIC_RELAXED, __HIP_MEMORY_SCOPE_AGENT); }
__device__ __forceinline__ unsigned xb_xcc_id() { return (unsigned)__builtin_amdgcn_s_getreg((3 << 11) | 20) & 0xFu; }
#define XB_SPIN(cond, bar) do { unsigned _sp = 0; while (cond) { __builtin_amdgcn_s_sleep(1); \
    if ((++_sp & 255u) == 0u) { if (xb_ld(&(bar)[XB_TMO])) break; if (_sp > XB_SPIN_CAP) { atomicAdd(&(bar)[XB_TMO], 1u); break; } } } } while (0)

struct XcdBarrier {
    unsigned* bar; unsigned x;
    volatile LAS unsigned* st;
};

__device__ __forceinline__ XcdBarrier xcd_barrier_post(unsigned* bar, volatile LAS unsigned* st) {
    XcdBarrier b; b.bar = bar; b.x = xb_xcc_id(); b.st = st;
    if (threadIdx.x == 0) (void)xb_add(&bar[XB_XCNT(b.x)], 1u);
    return b;
}
__device__ __forceinline__ void xcd_barrier_complete(unsigned* bar, unsigned x, unsigned& nloc, unsigned& nx) {
    const unsigned G = gridDim.x * gridDim.y * gridDim.z;
    unsigned sum, cnt, mine, sp = 0u;
    for (;;) {
        sum = 0u; cnt = 0u; mine = 0u;
#pragma unroll
        for (unsigned j = 0; j < 16; ++j) { const unsigned c = xb_ld(&bar[XB_XCNT(j)]); sum += c; cnt += (c > 0u) ? 1u : 0u; mine = (j == x) ? c : mine; }
        if (sum == G) break;
        __builtin_amdgcn_s_sleep(1);
        if ((++sp & 255u) == 0u) { if (xb_ld(&bar[XB_TMO])) break; if (sp > XB_SPIN_CAP) { atomicAdd(&bar[XB_TMO], 1u); break; } }
    }
    nloc = mine > 0u ? mine : 1u; nx = cnt > 0u ? cnt : 1u;
}

__device__ __forceinline__ void xcd_barrier(const XcdBarrier& b) {
    asm volatile("s_waitcnt vmcnt(0)" ::: "memory");
    __syncthreads();
    if (threadIdx.x == 0) {
        unsigned* bar = b.bar;
        __builtin_amdgcn_s_waitcnt(0);
        unsigned nloc = b.st[0], nx = b.st[1];
        if (nloc == 0u) { xcd_barrier_complete(bar, b.x, nloc, nx); b.st[0] = nloc; b.st[1] = nx; }
        const unsigned old = xb_add(&bar[XB_XSUB(b.x)], 1u);
        const unsigned gen = old / nloc;
        if (old + 1u == (gen + 1u) * nloc) {
            __builtin_amdgcn_fence(__ATOMIC_RELEASE, "agent");
            asm volatile("s_waitcnt vmcnt(0)" ::: "memory");
            const unsigned og = xb_add(&bar[XB_TOP], 1u);
            const unsigned tg = og / nx;
            if (og + 1u == (tg + 1u) * nx) xb_add(&bar[XB_TOPGEN], 1u);
            else XB_SPIN(xb_ld(&bar[XB_TOPGEN]) == tg, bar);
            __builtin_amdgcn_fence(__ATOMIC_ACQUIRE, "agent");
            xb_add(&bar[XB_XGEN(b.x)], 1u);
            asm volatile("s_waitcnt vmcnt(0)" ::: "memory");
        } else {
            XB_SPIN(xb_ld(&bar[XB_XGEN(b.x)]) == gen, bar);
            __builtin_amdgcn_fence(__ATOMIC_ACQUIRE, "agent");
            asm volatile("s_waitcnt vmcnt(0)" ::: "memory");
        }
    }
    __syncthreads();
}


DI void chunk_info(int b, int sc, int& seqbase, int& t0, int& slen) {
    if (sc < 2) { seqbase = NLAT + b * CTXL; t0 = sc * 128; slen = CTXL; } else { seqbase = b * SEQ; t0 = (sc - 2) * 128; slen = SEQ; }
}
constexpr int LD = 136;
constexpr int TILE_B = 128 * LD * 2;

template <int NT> DI void conv_wt_load(const Ctx& c, const float* cw, const float* cb, const int (&ch0)[NT], LAS float* wt) {
    if (c.tid < 192) { const int k = c.tid >> 5, j = c.tid & 31; const float* src = (k < 5 ? cw + k * 768 : cb) + 4 * j;
#pragma unroll
        for (int t = 0; t < NT; ++t) *(LAS f32x4*)(wt + t * 768 + k * 128 + 4 * j) = *(const f32x4*)(src + ch0[t]); }
}
DI void conv_load(const Ctx& c, const bf16* proj, const LAS float* wt, int seqbase, int t0, int slen, int ch0, LAS bf16* dst) {
    const int cg = c.tid & 15, tg = c.tid >> 4, ch = ch0 + 8 * cg, tb = t0 + 4 * tg - 2;
    u32x4 raw[8];
#pragma unroll
    for (int q = 0; q < 8; ++q) { const int tt = tb + q; raw[q] = (u32x4){0u, 0u, 0u, 0u};
        if (tt >= 0 && tt < slen) raw[q] = *(const u32x4*)(proj + (size_t)(seqbase + tt) * NPROJ + C_XBC + ch); }
    f32x4 w0[5], w1[5];
#pragma unroll
    for (int k = 0; k < 5; ++k) { w0[k] = *(const LAS f32x4*)(wt + k * 128 + 8 * cg); w1[k] = *(const LAS f32x4*)(wt + k * 128 + 8 * cg + 4); }
    const f32x4 b0 = *(const LAS f32x4*)(wt + 640 + 8 * cg), b1 = *(const LAS f32x4*)(wt + 640 + 8 * cg + 4);
#pragma unroll
    for (int o = 0; o < 4; ++o) {
        f32x4 a0 = b0, a1 = b1;
#pragma unroll
        for (int k = 0; k < 5; ++k) { const u32x4 r = raw[o + k];
            a0.x += bflo(r.x) * w0[k].x; a0.y += bfhi(r.x) * w0[k].y; a0.z += bflo(r.y) * w0[k].z; a0.w += bfhi(r.y) * w0[k].w;
            a1.x += bflo(r.z) * w1[k].x; a1.y += bfhi(r.z) * w1[k].y; a1.z += bflo(r.w) * w1[k].z; a1.w += bfhi(r.w) * w1[k].w; }
        u32x4 ov; ov.x = pk2(siluf(a0.x), siluf(a0.y)); ov.y = pk2(siluf(a0.z), siluf(a0.w)); ov.z = pk2(siluf(a1.x), siluf(a1.y)); ov.w = pk2(siluf(a1.z), siluf(a1.w));
        *(LAS u32x4*)(dst + (4 * tg + o) * LD + 8 * cg) = ov; }
}
DI void ml_load_qk(const Ctx& c, const bf16* proj, const float* rc, const float* rs, int rowbase, int t0, bool lat, int colbase, int hp, LAS bf16* dst) {
#pragma unroll
    for (int i = 0; i < 2; ++i) {
        const int idx = c.tid + NTHR * i, cq = idx & 3, hh = (idx >> 2) & 1, t = idx >> 3;
        const bf16* src = proj + (size_t)(rowbase + t) * NPROJ + colbase + (2 * hp + hh) * 64;
        u32x4 r1 = *(const u32x4*)(src + 8 * cq), r2 = *(const u32x4*)(src + 32 + 8 * cq);
        if (lat) {
            const float* cs = rc + (size_t)(t0 + t) * 32 + 8 * cq; const float* sn = rs + (size_t)(t0 + t) * 32 + 8 * cq;
            const f32x4 c0 = *(const f32x4*)cs, c1 = *(const f32x4*)(cs + 4), s0 = *(const f32x4*)sn, s1 = *(const f32x4*)(sn + 4);
            u32x4 o1, o2;
#define ROT(W, CA, SA, CB, SB) { const float x1a = bflo(r1.W), x1b = bfhi(r1.W), x2a = bflo(r2.W), x2b = bfhi(r2.W); \
            o1.W = pk2(x1a * CA - x2a * SA, x1b * CB - x2b * SB); o2.W = pk2(x1a * SA + x2a * CA, x1b * SB + x2b * CB); }
            ROT(x, c0.x, s0.x, c0.y, s0.y) ROT(y, c0.z, s0.z, c0.w, s0.w) ROT(z, c1.x, s1.x, c1.y, s1.y) ROT(w, c1.z, s1.z, c1.w, s1.w)
#undef ROT
            r1 = o1; r2 = o2; }
        *(LAS u32x4*)(dst + t * LD + hh * 64 + 8 * cq) = r1; *(LAS u32x4*)(dst + t * LD + hh * 64 + 32 + 8 * cq) = r2; }
}
DI void ml_load_qk2(const Ctx& c, const bf16* proj, const float* rc, const float* rs, int rowbase, int t0, bool lat, int hp, LAS bf16* dq, LAS bf16* dk) {
#pragma unroll
    for (int i = 0; i < 2; ++i) {
        const int idx = c.tid + NTHR * i, cq = idx & 3, hh = (idx >> 2) & 1, t = idx >> 3;
        const bf16* sq = proj + (size_t)(rowbase + t) * NPROJ + C_MLQ + (2 * hp + hh) * 64; const bf16* sk = sq + (C_MLK - C_MLQ);
        u32x4 r1 = *(const u32x4*)(sq + 8 * cq), r2 = *(const u32x4*)(sq + 32 + 8 * cq), k1 = *(const u32x4*)(sk + 8 * cq), k2 = *(const u32x4*)(sk + 32 + 8 * cq);
        if (lat) {
            const float* cs = rc + (size_t)(t0 + t) * 32 + 8 * cq; const float* sn = rs + (size_t)(t0 + t) * 32 + 8 * cq;
            const f32x4 c0 = *(const f32x4*)cs, c1 = *(const f32x4*)(cs + 4), s0 = *(const f32x4*)sn, s1 = *(const f32x4*)(sn + 4);
            u32x4 o1, o2, p1, p2;
#define ROT(A1, A2, O1, O2, W, CA, SA, CB, SB) { const float x1a = bflo(A1.W), x1b = bfhi(A1.W), x2a = bflo(A2.W), x2b = bfhi(A2.W); \
            O1.W = pk2(x1a * CA - x2a * SA, x1b * CB - x2b * SB); O2.W = pk2(x1a * SA + x2a * CA, x1b * SB + x2b * CB); }
            ROT(r1, r2, o1, o2, x, c0.x, s0.x, c0.y, s0.y) ROT(r1, r2, o1, o2, y, c0.z, s0.z, c0.w, s0.w) ROT(r1, r2, o1, o2, z, c1.x, s1.x, c1.y, s1.y) ROT(r1, r2, o1, o2, w, c1.z, s1.z, c1.w, s1.w)
            ROT(k1, k2, p1, p2, x, c0.x, s0.x, c0.y, s0.y) ROT(k1, k2, p1, p2, y, c0.z, s0.z, c0.w, s0.w) ROT(k1, k2, p1, p2, z, c1.x, s1.x, c1.y, s1.y) ROT(k1, k2, p1, p2, w, c1.z, s1.z, c1.w, s1.w)
#undef ROT
            r1 = o1; r2 = o2; k1 = p1; k2 = p2; }
        *(LAS u32x4*)(dq + t * LD + hh * 64 + 8 * cq) = r1; *(LAS u32x4*)(dq + t * LD + hh * 64 + 32 + 8 * cq) = r2;
        *(LAS u32x4*)(dk + t * LD + hh * 64 + 8 * cq) = k1; *(LAS u32x4*)(dk + t * LD + hh * 64 + 32 + 8 * cq) = k2; }
}
DI void ml_load_v(const Ctx& c, const bf16* proj, int rowbase, int colbase, int hp, LAS bf16* dst) {
#pragma unroll
    for (int i = 0; i < 4; ++i) { const int idx = c.tid + NTHR * i, cc = idx & 15, t = idx >> 4;
        *(LAS u32x4*)(dst + t * LD + 8 * cc) = *(const u32x4*)(proj + (size_t)(rowbase + t) * NPROJ + colbase + 2 * hp * 64 + 8 * cc); }
}

DI void ssd_states_task(const Ctx& c0, const Args& a, int layer, int b, int sc, int g) {
    Ctx c = c0; fresh_ctx(c);
    LAS bf16* Xs = (LAS bf16*)c.lds; LAS bf16* Bs = Xs + 128 * LD; LAS float* wts = (LAS float*)(c.lds + 2 * TILE_B);
    const bf16* proj = WSP(bf16, WS_PROJ); const float* gates = WSP(float, WS_GATES);
    int seqbase, t0, slen; chunk_info(b, sc, seqbase, t0, slen); const int rowbase = seqbase + t0;
    const float* cw = a.in[I_CONVW] + layer * 5 * 768; const float* cb = a.in[I_CONVB] + layer * 768;
    LAS float* wtab = (LAS float*)(c.lds + 3 * TILE_B);
    { const int chs[2] = {128 * g, 256 + 128 * g}; conv_wt_load<2>(c, cw, cb, chs, wtab); }
    __syncthreads();
    conv_load(c, proj, wtab, seqbase, t0, slen, 128 * g, Xs);
    conv_load(c, proj, wtab + 768, seqbase, t0, slen, 256 + 128 * g, Bs);
    if (c.wave < 4) {
        const int combo = c.wave, dir = combo >> 1, h = 2 * g + (combo & 1), dh = dir * 4 + h;
        const float ac = -__expf(a.in[I_ALOG][layer * 8 + dh]), dtb = a.in[I_DTB][layer * 8 + dh];
        const int ta = dir ? 127 - 2 * c.lane : 2 * c.lane, tb = dir ? 126 - 2 * c.lane : 2 * c.lane + 1;
        const float dta = softplusf(gates[(size_t)dh * NTOK + rowbase + ta] + dtb), dtb2 = softplusf(gates[(size_t)dh * NTOK + rowbase + tb] + dtb);
        const float la = dta * ac, lb = dtb2 * ac, s = la + lb, incl = scan_add(s, c.lane), excl = incl - s, total = rl_f(incl, 63);
        wts[combo * 128 + ta] = __expf(total - (excl + la)) * dta; wts[combo * 128 + tb] = __expf(total - incl) * dtb2;
        if (c.lane == 0) WSP(float, WS_MISC)[4 * NSIDX + ((b * 2 + dir) * 4 + h) * NSC + sc] = __expf(total);
    }
    __syncthreads();
    {
        const int combo = c.wave >> 1, half = c.wave & 1, dir = combo >> 1, hh = combo & 1, h = 2 * g + hh, gq = c.lane >> 4;
        bf16* S = WSP(bf16, WS_SSTB) + (size_t)(((b * 2 + dir) * 4 + h) * NSC + sc) * 8192;
        bf16x8 xw[4][4];
#pragma unroll
        for (int ks = 0; ks < 4; ++ks) { const LAS float* wp = wts + combo * 128 + 32 * ks + 8 * gq; const f32x4 w0 = *(const LAS f32x4*)wp, w1 = *(const LAS f32x4*)(wp + 4);
#pragma unroll
            for (int pb = 0; pb < 4; ++pb) xw[ks][pb] = scale_frag(frag_tr(Xs, LD, 32 * ks, 64 * hh + 16 * pb, c.lane), w0, w1); }
#pragma unroll
        for (int nb = 0; nb < 4; ++nb) { const int n0 = 16 * (4 * half + nb);
            f32x4 acc[4];
#pragma unroll
            for (int pb = 0; pb < 4; ++pb) acc[pb] = (f32x4){0.f, 0.f, 0.f, 0.f};
#pragma unroll
            for (int ks = 0; ks < 4; ++ks) { const bf16x8 af = frag_tr(Bs, LD, 32 * ks, n0, c.lane);
#pragma unroll
                for (int pb = 0; pb < 4; ++pb) acc[pb] = mfma16(af, xw[ks][pb], acc[pb]); }
#pragma unroll
            for (int q = 0; q < 2; ++q) { u32x2 wa, wb; wa.x = pk2(acc[2 * q].x, acc[2 * q].y); wa.y = pk2(acc[2 * q].z, acc[2 * q].w); wb.x = pk2(acc[2 * q + 1].x, acc[2 * q + 1].y); wb.y = pk2(acc[2 * q + 1].z, acc[2 * q + 1].w);
                const int sel = gq & 1; *(u32x4*)(S + (16 * (2 * q + sel) + (c.lane & 15)) * 128 + n0 + 4 * (gq - sel)) = widen16(wa, wb); } }
    }
    __syncthreads();
}
DI void ml_states_task(const Ctx& c0, const Args& a, int layer, int b, int sc, int hp) {
    Ctx c = c0; fresh_ctx(c);
    LAS bf16* Ks = (LAS bf16*)c.lds; LAS bf16* Vs = Ks + 128 * LD; LAS float* ew = (LAS float*)(c.lds + 2 * TILE_B);
    const bf16* proj = WSP(bf16, WS_PROJ); const float* gates = WSP(float, WS_GATES); float* misc = WSP(float, WS_MISC);
    int seqbase, t0, slen; chunk_info(b, sc, seqbase, t0, slen); const int rowbase = seqbase + t0;
    ml_load_qk(c, proj, WSP(float, WS_ROPE), WSP(float, WS_ROPE) + 8192 * 32, rowbase, t0, sc >= 2, C_MLK, hp, Ks);
    ml_load_v(c, proj, rowbase, C_MLV, hp, Vs);
    if (c.wave < 4) {
        const int combo = c.wave, dir = combo >> 1, h = 2 * hp + (combo & 1), dh = dir * 4 + h;
        const float bi = a.in[I_MLGB][layer * 16 + dir * 8 + h], bfg = a.in[I_MLGB][layer * 16 + dir * 8 + 4 + h];
        const int ta = dir ? 127 - 2 * c.lane : 2 * c.lane, tb = dir ? 126 - 2 * c.lane : 2 * c.lane + 1;
        const float* ga = gates + rowbase + ta; const float* gb = gates + rowbase + tb;
        const float lia = ga[(size_t)(8 + dh) * NTOK] + bi, lib = gb[(size_t)(8 + dh) * NTOK] + bi, lfa = logsigf(ga[(size_t)(16 + dh) * NTOK] + bfg), lfb = logsigf(gb[(size_t)(16 + dh) * NTOK] + bfg);
        const float s = lfa + lfb, incl = scan_add(s, c.lane), excl = incl - s, total = rl_f(incl, 63);
        const float aa = lia - (excl + lfa), ab = lib - incl, amax = wave_max(fmaxf(aa, ab));
        ew[combo * 128 + ta] = __expf(aa - amax); ew[combo * 128 + tb] = __expf(ab - amax);
        if (c.lane == 0) { const int sidx = ((b * 2 + dir) * 4 + h) * NSC + sc; misc[1 * NSIDX + sidx] = total; misc[0 * NSIDX + sidx] = total + amax; }
    }
    __syncthreads();
    {
        const int combo = c.wave >> 1, half = c.wave & 1, dir = combo >> 1, hh = combo & 1, h = 2 * hp + hh, gq = c.lane >> 4;
        bf16* Cst = WSP(bf16, WS_MCB) + (size_t)(((b * 2 + dir) * 4 + h) * NSC + sc) * 4096;
        bf16x8 vw[4][4];
#pragma unroll
        for (int ks = 0; ks < 4; ++ks) { const LAS float* wp = ew + combo * 128 + 32 * ks + 8 * gq; const f32x4 w0 = *(const LAS f32x4*)wp, w1 = *(const LAS f32x4*)(wp + 4);
#pragma unroll
            for (int eb = 0; eb < 4; ++eb) vw[ks][eb] = scale_frag(frag_tr(Vs, LD, 32 * ks, 64 * hh + 16 * eb, c.lane), w0, w1); }
#pragma unroll
        for (int db = 0; db < 2; ++db) { const int d0 = 16 * (2 * half + db);
            f32x4 acc[4];
#pragma unroll
            for (int eb = 0; eb < 4; ++eb) acc[eb] = (f32x4){0.f, 0.f, 0.f, 0.f};
#pragma unroll
            for (int ks = 0; ks < 4; ++ks) { const bf16x8 af = frag_tr(Ks, LD, 32 * ks, 64 * hh + d0, c.lane);
#pragma unroll
                for (int eb = 0; eb < 4; ++eb) acc[eb] = mfma16(af, vw[ks][eb], acc[eb]); }
#pragma unroll
            for (int q = 0; q < 2; ++q) { u32x2 wa, wb; wa.x = pk2(acc[2 * q].x, acc[2 * q].y); wa.y = pk2(acc[2 * q].z, acc[2 * q].w); wb.x = pk2(acc[2 * q + 1].x, acc[2 * q + 1].y); wb.y = pk2(acc[2 * q + 1].z, acc[2 * q + 1].w);
                const int sel = gq & 1; *(u32x4*)(Cst + (16 * (2 * q + sel) + (c.lane & 15)) * 64 + d0 + 4 * (gq - sel)) = widen16(wa, wb); } }
    }
    {
        const int combo = c.tid >> 7, d = (c.tid >> 1) & 63, hf = c.tid & 1, dir = combo >> 1, hh = combo & 1, h = 2 * hp + hh;
        float s = 0.f;
#pragma unroll 8
        for (int t = 64 * hf; t < 64 * hf + 64; ++t) s += ew[combo * 128 + t] * bf2f(Ks[t * LD + hh * 64 + d]);
        s += __shfl_xor(s, 1);
        if (!hf) WSP(float, WS_MISC)[8 * NSIDX + (size_t)(((b * 2 + dir) * 4 + h) * NSC + sc) * 64 + d] = s;
    }
    __syncthreads();
}
DI int q_pop_issue(const Ctx& c, unsigned* q); DI void q_publish(const Ctx& c, int v, int slot); DI int q_read(const Ctx& c, int slot);
constexpr int NA_FILL = 224;
DI void na_tasks(const Ctx& c0, const Args& a, int layer, int u0, int u1, int nA, int nT, unsigned* q, int qofs, int ubase);
DI void phase_local(const Ctx& c, const Args& a, int layer, int qid) {
    unsigned* q = WSP(unsigned, WS_CTL) + 196608 + 64 * qid;
    int cur = blockIdx.x, nxt;
    { const int v = q_pop_issue(c, q); q_publish(c, v, 0); __syncthreads(); nxt = q_read(c, 0); __syncthreads(); }
    while (cur < 1056) {
        const int nn = q_pop_issue(c, q);
        if (cur < 528) { const int b = cur / 132, rem = cur % 132; ssd_states_task(c, a, layer, b, rem >> 1, rem & 1); }
        else { const int u = cur - 528, b = u / 132, rem = u % 132; ml_states_task(c, a, layer, b, rem >> 1, rem & 1); }
        q_publish(c, nn, 0); __syncthreads(); cur = nxt; nxt = q_read(c, 0); __syncthreads();
    }
    if (cur < 1056 + NA_FILL) na_tasks(c, a, layer, cur - 1056, nxt - 1056, NB * 8 * 64, NA_FILL, q, 1056, 0);
}

DI int scan_sc(int dir, int step) { return dir == 0 ? step : (step < 2 ? 1 - step : 67 - step); }
DI void ld8(const bf16* p, f32x4& a, f32x4& b) { const u32x4 r = *(const u32x4*)p; a = (f32x4){bflo(r.x), bfhi(r.x), bflo(r.y), bfhi(r.y)}; b = (f32x4){bflo(r.z), bfhi(r.z), bflo(r.w), bfhi(r.w)}; }
DI void st8(bf16* p, f32x4 a, f32x4 b) { u32x4 w; w.x = pk2(a.x, a.y); w.y = pk2(a.z, a.w); w.z = pk2(b.x, b.y); w.w = pk2(b.z, b.w); *(u32x4*)p = w; }
DI void phase_scan(const Ctx& c) {
    float* misc = WSP(float, WS_MISC);
    constexpr int N_SSD = 32 * 1024, N_MLC = 32 * 512, N_MLN = 32 * 16, NBATCH = 6, BSZ = 11;
    static_assert(NBATCH * BSZ == NSC, "scan batches");
    for (int item = (blockIdx.x + c.G * c.wave) * 64 + c.lane; item < N_SSD + N_MLC + N_MLN; item += c.G * NWAVES * 64) {
        const bool is_ssd = item < N_SSD; const int it = item - N_SSD; const bool isc = it < N_MLC;
        const int chain = is_ssd ? item >> 10 : (isc ? it >> 9 : (it - N_MLC) >> 4), dir = (chain >> 2) & 1;
        char* base; size_t stride;
        if (is_ssd) { base = (char*)(WSP(bf16, WS_SSTB) + (size_t)chain * NSC * 8192 + 8 * (item & 1023)); stride = 8192 * 2; }
        else if (isc) { base = (char*)(WSP(bf16, WS_MCB) + (size_t)chain * NSC * 4096 + 8 * (it & 511)); stride = 4096 * 2; }
        else { base = (char*)(misc + 8 * NSIDX + (size_t)chain * NSC * 64 + 4 * ((it - N_MLC) & 15)); stride = 64 * 4; }
        const float* dec = misc + 4 * NSIDX + chain * NSC; const float* mm = misc + chain * NSC; const float* mg = misc + NSIDX + chain * NSC; float* mmin = misc + 2 * NSIDX + chain * NSC;
        const bool wr_m = !is_ssd && !isc && ((it - N_MLC) & 15) == 0;
        f32x4 s0 = {0.f, 0.f, 0.f, 0.f}, s1 = s0; float m = 0.f;
        u32x4 cur[BSZ], nxt[BSZ];
#pragma unroll
        for (int j = 0; j < BSZ; ++j) cur[j] = *(const u32x4*)(base + (size_t)scan_sc(dir, j) * stride);
#pragma unroll 1
        for (int bt = 0; bt < NBATCH; ++bt) {
            if (bt + 1 < NBATCH) {
#pragma unroll
                for (int j = 0; j < BSZ; ++j) nxt[j] = *(const u32x4*)(base + (size_t)scan_sc(dir, (bt + 1) * BSZ + j) * stride); }
#pragma unroll
            for (int j = 0; j < BSZ; ++j) {
                const int sc = scan_sc(dir, bt * BSZ + j); const u32x4 r = cur[j]; u32x4* p = (u32x4*)(base + (size_t)sc * stride);
                if (is_ssd || isc) {
                    const f32x4 c0 = {bflo(r.x), bfhi(r.x), bflo(r.y), bfhi(r.y)}, c1 = {bflo(r.z), bfhi(r.z), bflo(r.w), bfhi(r.w)};
                    u32x4 w; w.x = pk2(s0.x, s0.y); w.y = pk2(s0.z, s0.w); w.z = pk2(s1.x, s1.y); w.w = pk2(s1.z, s1.w); *p = w;
                    if (is_ssd) { const float d = dec[sc]; s0 = s0 * d + c0; s1 = s1 * d + c1; }
                    else { const float ml = mm[sc], gc = mg[sc], mn = fmaxf(gc + m, ml), ao = __expf(gc + m - mn), an = __expf(ml - mn); s0 = s0 * ao + c0 * an; s1 = s1 * ao + c1 * an; m = mn; }
                } else {
                    const f32x4 c0 = __builtin_bit_cast(f32x4, r); *p = __builtin_bit_cast(u32x4, s0); if (wr_m) mmin[sc] = m;
                    const float ml = mm[sc], gc = mg[sc], mn = fmaxf(gc + m, ml), ao = __expf(gc + m - mn), an = __expf(ml - mn); s0 = s0 * ao + c0 * an; m = mn;
                }
            }
#pragma unroll
            for (int j = 0; j < BSZ; ++j) cur[j] = nxt[j];
        }
    }
}

DI void ssd_out_task(const Ctx& c0, const Args& a, int layer, int b, int sc) {
    Ctx c = c0; fresh_ctx(c);
    LAS bf16* Xs = (LAS bf16*)c.lds; LAS bf16* Bs = Xs + 128 * LD; LAS bf16* Cs = Bs + 128 * LD;
    LAS float* acum = (LAS float*)(c.lds + 3 * TILE_B); LAS float* dtv = acum + 512;
    const bf16* proj = WSP(bf16, WS_PROJ); const float* gates = WSP(float, WS_GATES);
    int seqbase, t0, slen; chunk_info(b, sc, seqbase, t0, slen); const int rowbase = seqbase + t0;
    const float* cw = a.in[I_CONVW] + layer * 5 * 768; const float* cb = a.in[I_CONVB] + layer * 768;
    const int ci = c.lane & 15, gq = c.lane >> 4, irow = 16 * c.wave + ci;
    const size_t row = (size_t)rowbase + irow; bf16* mix = WSP(bf16, WS_MIX);
    float ssq = 0.f;
    LAS float* gtab = (LAS float*)(c.lds + 3 * TILE_B + 4096 + 2 * 64 * LD * 2);
    if (c.tid < 64) *(LAS f32x4*)(gtab + 4 * c.tid) = *(const f32x4*)(a.in[I_SSMG] + layer * 256 + 4 * c.tid);
#pragma unroll 1
    for (int g = 0; g < 2; ++g) {
        fresh_ctx(c);
        const int ci = c.lane & 15, gq = c.lane >> 4, irow = 16 * c.wave + ci; const size_t row = (size_t)rowbase + irow;
        if (g) __syncthreads();
        LAS bf16* St = (LAS bf16*)(c.lds + 3 * TILE_B + 4096);
        const bf16* sbase = WSP(bf16, WS_SSTB) + (size_t)sc * 8192 + 8 * c.tid;
        const size_t sd0 = (size_t)(((b * 2 + 0) * 4 + 2 * g) * NSC) * 8192, sd1 = (size_t)(((b * 2 + 1) * 4 + 2 * g) * NSC) * 8192, shd = (size_t)NSC * 8192;
        u32x4 sa0 = *(const u32x4*)(sbase + sd0), sa1 = *(const u32x4*)(sbase + sd0 + 4096), sb0 = *(const u32x4*)(sbase + sd1), sb1 = *(const u32x4*)(sbase + sd1 + 4096);
        LAS bf16* stw = St + (c.tid >> 4) * LD + 8 * (c.tid & 15);
        LAS float* wtab = (LAS float*)St;
        { const int chs[3] = {128 * g, 256 + 128 * g, 512 + 128 * g}; conv_wt_load<3>(c, cw, cb, chs, wtab); }
        __syncthreads();
        conv_load(c, proj, wtab, seqbase, t0, slen, 128 * g, Xs);
        conv_load(c, proj, wtab + 768, seqbase, t0, slen, 256 + 128 * g, Bs);
        conv_load(c, proj, wtab + 1536, seqbase, t0, slen, 512 + 128 * g, Cs);
        __syncthreads();
        *(LAS u32x4*)stw = sa0; *(LAS u32x4*)(stw + 32 * LD) = sa1; *(LAS u32x4*)(stw + 64 * LD) = sb0; *(LAS u32x4*)(stw + 96 * LD) = sb1;
        if (c.wave < 4) {
            const int combo = c.wave, dir = combo >> 1, h = 2 * g + (combo & 1), dh = dir * 4 + h;
            const float ac = -__expf(a.in[I_ALOG][layer * 8 + dh]), dtb = a.in[I_DTB][layer * 8 + dh];
            const int ta = dir ? 127 - 2 * c.lane : 2 * c.lane, tb = dir ? 126 - 2 * c.lane : 2 * c.lane + 1;
            const float dta = softplusf(gates[(size_t)dh * NTOK + rowbase + ta] + dtb), dtb2 = softplusf(gates[(size_t)dh * NTOK + rowbase + tb] + dtb);
            const float la = dta * ac, lb = dtb2 * ac, s = la + lb, incl = scan_add(s, c.lane), excl = incl - s;
            acum[combo * 128 + ta] = excl + la; acum[combo * 128 + tb] = incl; dtv[combo * 128 + ta] = dta; dtv[combo * 128 + tb] = dtb2;
        }
        __syncthreads();
        f32x4 accY[2][4];
#pragma unroll
        for (int hh = 0; hh < 2; ++hh)
#pragma unroll
            for (int pb = 0; pb < 4; ++pb) accY[hh][pb] = (f32x4){0.f, 0.f, 0.f, 0.f};
        u32x2 zq[2][4];
#pragma unroll
        for (int hh = 0; hh < 2; ++hh)
#pragma unroll
            for (int pb = 0; pb < 4; ++pb) zq[hh][pb] = *(const u32x2*)(proj + row * NPROJ + C_Z + (2 * g + hh) * 64 + 16 * pb + 4 * gq);
        sa0 = *(const u32x4*)(sbase + sd0 + shd); sa1 = *(const u32x4*)(sbase + sd0 + shd + 4096); sb0 = *(const u32x4*)(sbase + sd1 + shd); sb1 = *(const u32x4*)(sbase + sd1 + shd + 4096);
        f32x4 accG[8];
#pragma unroll
        for (int jb = 0; jb < 8; ++jb) accG[jb] = (f32x4){0.f, 0.f, 0.f, 0.f};
#pragma unroll
        for (int ks = 0; ks < 4; ++ks) { const bf16x8 cq = frag_kc(Cs, LD, 16 * c.wave, 32 * ks, c.lane);
#pragma unroll
            for (int jb = 0; jb < 8; ++jb) accG[jb] = mfma16(frag_kc(Bs, LD, 16 * jb, 32 * ks, c.lane), cq, accG[jb]); }
#pragma unroll
        for (int cc = 0; cc < 4; ++cc) {
            asm volatile("" ::: "memory");
            const int hh = cc >> 1, dir = cc & 1, combo = dir * 2 + hh;
            if (cc == 2) { __syncthreads(); *(LAS u32x4*)stw = sa0; *(LAS u32x4*)(stw + 32 * LD) = sa1; *(LAS u32x4*)(stw + 64 * LD) = sb0; *(LAS u32x4*)(stw + 96 * LD) = sb1; __syncthreads(); }
            const float ai = acum[combo * 128 + irow];
            {
                f32x4 accI[4];
#pragma unroll
                for (int pb = 0; pb < 4; ++pb) accI[pb] = (f32x4){0.f, 0.f, 0.f, 0.f};
#pragma unroll
                for (int ks = 0; ks < 4; ++ks) { const bf16x8 cq = frag_kc(Cs, LD, 16 * c.wave, 32 * ks, c.lane);
#pragma unroll
                    for (int pb = 0; pb < 4; ++pb) accI[pb] = mfma16(frag_kc(St + dir * 64 * LD, LD, 16 * pb, 32 * ks, c.lane), cq, accI[pb]); }
                const float ei = __expf(ai);
#pragma unroll
                for (int pb = 0; pb < 4; ++pb) accY[hh][pb] += accI[pb] * ei;
            }
#pragma unroll
            for (int jp = 0; jp < 4; ++jp) {
                asm volatile("" ::: "memory");
                const bool skip = dir == 0 ? (2 * jp > c.wave) : (2 * jp + 1 < c.wave);
                if (!skip) {
                    const int j0 = 32 * jp + 4 * gq;
                    const f32x4 aa = *(const LAS f32x4*)(acum + combo * 128 + j0), ab = *(const LAS f32x4*)(acum + combo * 128 + j0 + 16);
                    const f32x4 da = *(const LAS f32x4*)(dtv + combo * 128 + j0), db = *(const LAS f32x4*)(dtv + combo * 128 + j0 + 16);
                    f32x4 wa, wb;
#pragma unroll
                    for (int r = 0; r < 4; ++r) { const int ja = j0 + r, jb2 = j0 + 16 + r;
                        const bool ma = dir == 0 ? (ja <= irow) : (ja >= irow), mb = dir == 0 ? (jb2 <= irow) : (jb2 >= irow);
                        wa[r] = ma ? __expf(ai - aa[r]) * da[r] : 0.f; wb[r] = mb ? __expf(ai - ab[r]) * db[r] : 0.f; }
                    const bf16x8 pf = pack_acc(accG[2 * jp] * wa, accG[2 * jp + 1] * wb);
#pragma unroll
                    for (int pb = 0; pb < 4; ++pb) accY[hh][pb] = mfma16(frag_trp(Xs, LD, 32 * jp, 64 * hh + 16 * pb, c.lane), pf, accY[hh][pb]);
                }
            }
        }
#pragma unroll
        for (int hh = 0; hh < 2; ++hh) { const int h = 2 * g + hh; const float dsk = a.in[I_SSMD][layer * 8 + h] + a.in[I_SSMD][layer * 8 + 4 + h];
#pragma unroll
            for (int q = 0; q < 2; ++q) { u32x2 wp[2];
#pragma unroll
                for (int pp = 0; pp < 2; ++pp) { const int pb = 2 * q + pp; const u32x2 xr = *(const LAS u32x2*)(Xs + irow * LD + 64 * hh + 16 * pb + 4 * gq);
                    const u32x2 zr = zq[hh][pb];
                    f32x4 v = accY[hh][pb] + (f32x4){bflo(xr.x), bfhi(xr.x), bflo(xr.y), bfhi(xr.y)} * dsk;
                    v.x *= siluf(bflo(zr.x)); v.y *= siluf(bfhi(zr.x)); v.z *= siluf(bflo(zr.y)); v.w *= siluf(bfhi(zr.y));
                    ssq += (v.x * v.x + v.y * v.y) + (v.z * v.z + v.w * v.w);
                    wp[pp].x = pk2(v.x, v.y); wp[pp].y = pk2(v.z, v.w); }
                const int sel = gq & 1;
                *(u32x4*)(mix + row * 1024 + 512 + h * 64 + 32 * q + 16 * sel + 4 * (gq - sel)) = widen16(wp[0], wp[1]); } }
    }
    ssq = col4_sum(ssq);
    const float rstd = rsqrtf(ssq * (1.f / 256.f) + EPS);
    asm volatile("s_waitcnt vmcnt(0)" ::: "memory");
#pragma unroll
    for (int hq = 0; hq < 4; ++hq)
#pragma unroll
        for (int q = 0; q < 2; ++q) { const int sel = gq & 1, ch = hq * 64 + 32 * q + 16 * sel + 4 * (gq - sel); const LAS float* gp = gtab + ch; const f32x4 g0 = *(const LAS f32x4*)gp, g1 = *(const LAS f32x4*)(gp + 4);
            u32x4* p = (u32x4*)(mix + row * 1024 + 512 + ch); const u32x4 vr = *p;
            u32x4 w; w.x = pk2(bflo(vr.x) * rstd * g0.x, bfhi(vr.x) * rstd * g0.y); w.y = pk2(bflo(vr.y) * rstd * g0.z, bfhi(vr.y) * rstd * g0.w);
            w.z = pk2(bflo(vr.z) * rstd * g1.x, bfhi(vr.z) * rstd * g1.y); w.w = pk2(bflo(vr.w) * rstd * g1.z, bfhi(vr.w) * rstd * g1.w); *p = w; }
    __syncthreads();
}

DI void ml_out_task(const Ctx& c0, const Args& a, int layer, int b, int sc, int hp) {
    Ctx c = c0; fresh_ctx(c);
    LAS bf16* Qs = (LAS bf16*)c.lds; LAS bf16* Ks = Qs + 128 * LD; LAS bf16* Vs = Ks + 128 * LD;
    LAS float* av = (LAS float*)(c.lds + 3 * TILE_B); LAS float* Mv = av + 512; LAS float* bcv = Mv + 512;
    const bf16* proj = WSP(bf16, WS_PROJ); const float* gates = WSP(float, WS_GATES); const float* misc = WSP(float, WS_MISC);
    int seqbase, t0, slen; chunk_info(b, sc, seqbase, t0, slen); const int rowbase = seqbase + t0;
    const float* rc = WSP(float, WS_ROPE); const float* rs = rc + 8192 * 32;
    LAS float* gtab = (LAS float*)(c.lds + 3 * TILE_B + 6144 + 2 * 64 * 72 * 2 + 512);
    if (c.tid < 32) *(LAS f32x4*)(gtab + 4 * c.tid) = *(const f32x4*)(a.in[I_MLG] + layer * 256 + 2 * hp * 64 + 4 * c.tid);
    ml_load_qk2(c, proj, rc, rs, rowbase, t0, sc >= 2, hp, Qs, Ks);
    ml_load_v(c, proj, rowbase, C_MLV, hp, Vs);
    if (c.wave < 4) {
        const int combo = c.wave, dir = combo >> 1, h = 2 * hp + (combo & 1), dh = dir * 4 + h;
        const float bi = a.in[I_MLGB][layer * 16 + dir * 8 + h], bfg = a.in[I_MLGB][layer * 16 + dir * 8 + 4 + h];
        const int ta = dir ? 127 - 2 * c.lane : 2 * c.lane, tb = dir ? 126 - 2 * c.lane : 2 * c.lane + 1;
        const float* ga = gates + rowbase + ta; const float* gb = gates + rowbase + tb;
        const float lia = ga[(size_t)(8 + dh) * NTOK] + bi, lib = gb[(size_t)(8 + dh) * NTOK] + bi, lfa = logsigf(ga[(size_t)(16 + dh) * NTOK] + bfg), lfb = logsigf(gb[(size_t)(16 + dh) * NTOK] + bfg);
        const float s = lfa + lfb, incl = scan_add(s, c.lane), excl = incl - s;
        const float bca = excl + lfa, bcb = incl, aa = lia - bca, ab = lib - bcb;
        const float im = scan_max(fmaxf(aa, ab), c.lane); float em = __shfl_up(im, 1); if (c.lane == 0) em = -INFINITY;
        const float m_in = misc[2 * NSIDX + ((b * 2 + dir) * 4 + h) * NSC + sc];
        av[combo * 128 + ta] = aa; av[combo * 128 + tb] = ab;
        Mv[combo * 128 + ta] = fmaxf(fmaxf(em, aa), m_in); Mv[combo * 128 + tb] = fmaxf(im, m_in);
        bcv[combo * 128 + ta] = bca; bcv[combo * 128 + tb] = bcb;
    }
    __syncthreads();
    const int ci = c.lane & 15, gq = c.lane >> 4, irow = 16 * c.wave + ci;
    const size_t row = (size_t)rowbase + irow; bf16* mix = WSP(bf16, WS_MIX);
#pragma unroll 1
    for (int hh = 0; hh < 2; ++hh) {
        fresh_ctx(c);
        const int ci = c.lane & 15, gq = c.lane >> 4, irow = 16 * c.wave + ci; const size_t row = (size_t)rowbase + irow;
        const int h = 2 * hp + hh;
        LAS bf16* StM = (LAS bf16*)(c.lds + 3 * TILE_B + 6144); LAS float* nvs = (LAS float*)(StM + 2 * 64 * 72);
        const int sx0 = ((b * 2 + 0) * 4 + h) * NSC + sc, sx1 = ((b * 2 + 1) * 4 + h) * NSC + sc;
        const u32x4 st0 = *(const u32x4*)(WSP(bf16, WS_MCB) + (size_t)sx0 * 4096 + 8 * c.tid), st1 = *(const u32x4*)(WSP(bf16, WS_MCB) + (size_t)sx1 * 4096 + 8 * c.tid);
        u32x2 orq[4];
#pragma unroll
        for (int eb = 0; eb < 4; ++eb) orq[eb] = *(const u32x2*)(proj + row * NPROJ + C_MLO + h * 64 + 16 * eb + 4 * gq);
        f32x4 nvr = (f32x4){0.f, 0.f, 0.f, 0.f}; if (c.tid < 32) nvr = *(const f32x4*)(misc + 8 * NSIDX + (size_t)(c.tid < 16 ? sx0 : sx1) * 64 + 4 * (c.tid & 15));
        f32x4 accH[4];
#pragma unroll
        for (int eb = 0; eb < 4; ++eb) accH[eb] = (f32x4){0.f, 0.f, 0.f, 0.f};
        f32x4 accS[8];
#pragma unroll
        for (int jb = 0; jb < 8; ++jb) accS[jb] = (f32x4){0.f, 0.f, 0.f, 0.f};
#pragma unroll
        for (int ks = 0; ks < 2; ++ks) { const bf16x8 qf = frag_kc(Qs, LD, 16 * c.wave, 64 * hh + 32 * ks, c.lane);
#pragma unroll
            for (int jb = 0; jb < 8; ++jb) accS[jb] = mfma16(frag_kc(Ks, LD, 16 * jb, 64 * hh + 32 * ks, c.lane), qf, accS[jb]); }
        if (hh) __syncthreads();
        *(LAS u32x4*)(StM + (c.tid >> 3) * 72 + 8 * (c.tid & 7)) = st0; *(LAS u32x4*)(StM + 64 * 72 + (c.tid >> 3) * 72 + 8 * (c.tid & 7)) = st1;
        if (c.tid < 32) *(LAS f32x4*)(nvs + 4 * c.tid) = nvr;
        __syncthreads();
#pragma unroll
        for (int dir = 0; dir < 2; ++dir) {
            asm volatile("" ::: "memory");
            const int combo = dir * 2 + hh, sidx = ((b * 2 + dir) * 4 + h) * NSC + sc;
            const float Mi = Mv[combo * 128 + irow], m_in = misc[2 * NSIDX + sidx], inter = __expf(m_in - Mi) * 0.125f;
            f32x4 accN[4], accC[4];
#pragma unroll
            for (int eb = 0; eb < 4; ++eb) { accN[eb] = (f32x4){0.f, 0.f, 0.f, 0.f}; accC[eb] = (f32x4){0.f, 0.f, 0.f, 0.f}; }
            float dsum = 0.f;
#pragma unroll
            for (int jp = 0; jp < 4; ++jp) {
                asm volatile("" ::: "memory");
                const bool skip = dir == 0 ? (2 * jp > c.wave) : (2 * jp + 1 < c.wave);
                if (!skip) {
                    const int j0 = 32 * jp + 4 * gq;
                    const f32x4 aa = *(const LAS f32x4*)(av + combo * 128 + j0), ab = *(const LAS f32x4*)(av + combo * 128 + j0 + 16);
                    f32x4 sa, sb;
#pragma unroll
                    for (int r = 0; r < 4; ++r) { const int ja = j0 + r, jb2 = j0 + 16 + r;
                        const bool ma = dir == 0 ? (ja <= irow) : (ja >= irow), mb = dir == 0 ? (jb2 <= irow) : (jb2 >= irow);
                        sa[r] = ma ? accS[2 * jp][r] * (__expf(aa[r] - Mi) * 0.125f) : 0.f; sb[r] = mb ? accS[2 * jp + 1][r] * (__expf(ab[r] - Mi) * 0.125f) : 0.f; }
                    dsum += (sa.x + sa.y) + (sa.z + sa.w) + (sb.x + sb.y) + (sb.z + sb.w);
                    const bf16x8 pf = pack_acc(sa, sb);
#pragma unroll
                    for (int eb = 0; eb < 4; ++eb) accN[eb] = mfma16(frag_trp(Vs, LD, 32 * jp, 64 * hh + 16 * eb, c.lane), pf, accN[eb]);
                }
            }
#pragma unroll
            for (int ks = 0; ks < 2; ++ks) { const bf16x8 qf = frag_kc(Qs, LD, 16 * c.wave, 64 * hh + 32 * ks, c.lane);
#pragma unroll
                for (int eb = 0; eb < 4; ++eb) accC[eb] = mfma16(frag_kc(StM + dir * 64 * 72, 72, 16 * eb, 32 * ks, c.lane), qf, accC[eb]); }
            const LAS float* nin = nvs + dir * 64 + 16 * gq;
            const u32x4 q0 = *(const LAS u32x4*)(Qs + irow * LD + 64 * hh + 16 * gq), q1 = *(const LAS u32x4*)(Qs + irow * LD + 64 * hh + 16 * gq + 8);
            const f32x4 n0 = *(const LAS f32x4*)nin, n1 = *(const LAS f32x4*)(nin + 4), n2 = *(const LAS f32x4*)(nin + 8), n3 = *(const LAS f32x4*)(nin + 12);
            float nq = bflo(q0.x) * n0.x + bfhi(q0.x) * n0.y + bflo(q0.y) * n0.z + bfhi(q0.y) * n0.w + bflo(q0.z) * n1.x + bfhi(q0.z) * n1.y + bflo(q0.w) * n1.z + bfhi(q0.w) * n1.w
                     + bflo(q1.x) * n2.x + bfhi(q1.x) * n2.y + bflo(q1.y) * n2.z + bfhi(q1.y) * n2.w + bflo(q1.z) * n3.x + bfhi(q1.z) * n3.y + bflo(q1.w) * n3.z + bfhi(q1.w) * n3.w;
            nq = col4_sum(nq);
            dsum = col4_sum(dsum);
            const float den = dsum + inter * nq, mi = bcv[combo * 128 + irow] + Mi;
            const float inv = __builtin_amdgcn_rcpf(fmaxf(fabsf(den), __expf(-mi)));
#pragma unroll
            for (int eb = 0; eb < 4; ++eb) accH[eb] += (accN[eb] + accC[eb] * inter) * inv;
        }
        { float ssq = 0.f;
#pragma unroll
        for (int eb = 0; eb < 4; ++eb) { const u32x2 orw = orq[eb];
            f32x4 v = accH[eb]; v.x *= sigmf(bflo(orw.x)); v.y *= sigmf(bfhi(orw.x)); v.z *= sigmf(bflo(orw.y)); v.w *= sigmf(bfhi(orw.y));
            accH[eb] = v; ssq += (v.x * v.x + v.y * v.y) + (v.z * v.z + v.w * v.w); }
        ssq = col4_sum(ssq);
        const float rstd = rsqrtf(ssq * (1.f / 64.f) + EPS);
#pragma unroll
        for (int q = 0; q < 2; ++q) { u32x2 wp[2];
#pragma unroll
            for (int pp = 0; pp < 2; ++pp) { const int e = 16 * (2 * q + pp) + 4 * gq; const f32x4 gg = *(const LAS f32x4*)(gtab + hh * 64 + e);
                const f32x4 o = accH[2 * q + pp] * rstd * gg; wp[pp].x = pk2(o.x, o.y); wp[pp].y = pk2(o.z, o.w); }
            const int sel = gq & 1; *(u32x4*)(mix + row * 1024 + 768 + h * 64 + 32 * q + 16 * sel + 4 * (gq - sel)) = widen16(wp[0], wp[1]); } }
    }
    __syncthreads();
}


constexpr int CW_Q = 196608;
DI int q_pop_issue(const Ctx& c, unsigned* q) { int v = 0; if (c.tid == 0) v = c.G + (int)__hip_atomic_fetch_add(q, 1u, __ATOMIC_RELAXED, __HIP_MEMORY_SCOPE_AGENT); return v; }
DI void q_publish(const Ctx& c, int v, int slot) { if (c.tid == 0) ((volatile LAS int*)(c.lds + MISC_OFF))[16 + slot] = v; }
DI int q_read(const Ctx& c, int slot) { return __builtin_amdgcn_readfirstlane(((volatile LAS int*)(c.lds + MISC_OFF))[16 + slot]); }
constexpr int KVLD = 72, NA_NIT = 13;
struct NaTask { int b, h, rp, ctxq; };
DI NaTask na_decode(int u, int nA) { NaTask t; if (u < nA) { t.b = u >> 9; t.h = (u >> 6) & 7; t.rp = u & 63; t.ctxq = 0; } else { const int v = u - nA; t.b = v >> 4; t.h = (v >> 1) & 7; t.rp = v & 1; t.ctxq = 1; } return t; }
DI int na_rs(int rp) { const int r0a = 2 * rp < 4 ? 0 : (2 * rp > 124 ? 120 : 2 * rp - 4); return r0a > 119 ? 119 : r0a; }
DI void kv_issue(const Ctx& c, const bf16* proj, int col, int b, int rs, int nit, u32x4 (&raw)[NA_NIT]) {
    const int kq = c.tid >> 3, ch = c.tid & 7;
    const bf16* pc = proj + (size_t)(NLAT + b * CTXL + kq) * NPROJ + col + 8 * ch;
    const bf16* pw = proj + (size_t)(b * SEQ + rs * 64 + kq) * NPROJ + col + 8 * ch;
#pragma unroll
    for (int i = 0; i < NA_NIT; ++i) { raw[i] = (u32x4){0u, 0u, 0u, 0u};
        if (i < nit) raw[i] = i < 4 ? *(const u32x4*)(pc + (size_t)i * 64 * NPROJ) : *(const u32x4*)(pw + (size_t)(i - 4) * 64 * NPROJ); }
}
DI void kv_commit(const Ctx& c, int nit, LAS bf16* KV, u32x4 (&raw)[NA_NIT]) {
    LAS bf16* p = KV + (c.tid >> 3) * KVLD + 8 * (c.tid & 7);
#pragma unroll
    for (int i = 0; i < NA_NIT; ++i) if (i < nit) *(LAS u32x4*)(p + i * 64 * KVLD) = raw[i];
}
DI void na_softmax(f32x4 (&S)[16], float& m, float& l, bf16x8 (&P)[8]) {
    m = -INFINITY;
#pragma unroll
    for (int kb = 0; kb < 16; ++kb) m = fmaxf(m, fmaxf(fmaxf(S[kb].x, S[kb].y), fmaxf(S[kb].z, S[kb].w)));
    m = col4_max(m);
    l = 0.f;
#pragma unroll
    for (int kb = 0; kb < 16; ++kb) {
#pragma unroll
        for (int q = 0; q < 4; ++q) { const float p = __builtin_amdgcn_exp2f(S[kb][q] - m); S[kb][q] = p; l += p; } }
    l = col4_sum(l);
#pragma unroll
    for (int kp = 0; kp < 8; ++kp) P[kp] = pack_acc(S[2 * kp], S[2 * kp + 1]);
}
DI void na_tasks(const Ctx& c0, const Args& a, int layer, int u0, int u1, int nA, int nT, unsigned* q, int qofs, int ubase) {
    Ctx c = c0; fresh_ctx(c);
    LAS bf16* KV = (LAS bf16*)c.lds; LAS float* rpbs = (LAS float*)(c.lds + 139264);
    const bf16* proj = WSP(bf16, WS_PROJ);
    u32x4 kvr[NA_NIT];
    if (u0 < nT) { const NaTask t = na_decode(u0 + ubase, nA); kv_issue(c, proj, C_NAK + t.h * 64, t.b, na_rs(t.rp), t.ctxq ? 4 : NA_NIT, kvr); }
    int u = u0, un = u1;
    while (u < nT) {
        fresh_ctx(c);
        const int nn = q_pop_issue(c, q) - qofs;
        const int ci = c.lane & 15, gq = c.lane >> 4, rw = c.wave >> 2, qg = c.wave & 3, wq = 16 * qg + ci;
        const int cbase = qg == 0 ? 0 : (qg == 1 ? 8 : (qg == 2 ? 24 : 32));
        const NaTask t = na_decode(u + ubase, nA); const int b = t.b, h = t.h, rs = na_rs(t.rp), nit = t.ctxq ? 4 : NA_NIT;
        const bool ctxq = t.ctxq != 0;
        const int r = 2 * t.rp + rw, r0 = r < 4 ? 0 : (r > 124 ? 120 : r - 4), ioff = r0 - rs;
        if (!ctxq) for (int i = c.tid; i < 465; i += NTHR) rpbs[i] = a.in[I_RPB][(layer * 8 + h) * 465 + i] * LOG2E;
        const size_t qrow = ctxq ? (size_t)NLAT + b * CTXL + t.rp * 128 + 16 * c.wave + ci : (size_t)b * SEQ + r * 64 + wq;
        bf16x8 qf[2];
        { const bf16* qs = proj + qrow * NPROJ + C_NAQ + h * 64; qf[0] = *(const bf16x8*)(qs + 8 * gq); qf[1] = *(const bf16x8*)(qs + 32 + 8 * gq); }
        kv_commit(c, nit, KV, kvr);
        __syncthreads();
        float m1, l1, m2 = -INFINITY, l2 = 0.f; bf16x8 P1[8], P2[8];
        {
            f32x4 S[16];
#pragma unroll
            for (int kb = 0; kb < 16; ++kb) { if ((kb & 3) == 0) asm volatile("" ::: "memory"); S[kb] = mfma16(frag_kc(KV, KVLD, 16 * kb, 0, c.lane), qf[0], (f32x4){0.f, 0.f, 0.f, 0.f}); S[kb] = mfma16(frag_kc(KV, KVLD, 16 * kb, 32, c.lane), qf[1], S[kb]); }
            na_softmax(S, m1, l1, P1);
        }
        kv_issue(c, proj, C_NAV + h * 64, b, rs, nit, kvr);
        const int wrow = 256 + ioff * 64 + cbase;
        if (!ctxq) {
            f32x4 S[16];
#pragma unroll
            for (int kb = 0; kb < 16; ++kb) { if ((kb & 3) == 0) asm volatile("" ::: "memory"); const int row0 = wrow + (kb >> 1) * 64 + 16 * (kb & 1);
                S[kb] = mfma16(frag_kc(KV, KVLD, row0, 0, c.lane), qf[0], (f32x4){0.f, 0.f, 0.f, 0.f}); S[kb] = mfma16(frag_kc(KV, KVLD, row0, 32, c.lane), qf[1], S[kb]); }
            const int cw0 = wq < 8 ? 0 : (wq > 56 ? 48 : wq - 8);
#pragma unroll
            for (int kb = 0; kb < 16; ++kb) { if ((kb & 3) == 0) asm volatile("" ::: "memory"); const int dr = r0 + (kb >> 1) - r + 7;
#pragma unroll
                for (int q = 0; q < 4; ++q) { const int kc = cbase + 16 * (kb & 1) + 4 * gq + q; const bool valid = kc >= cw0 && kc < cw0 + 16;
                    const int dc = kc - wq + 15;
                    S[kb][q] = valid ? S[kb][q] + rpbs[dr * 31 + dc] : -INFINITY; } }
            na_softmax(S, m2, l2, P2);
        }
        __syncthreads();
        kv_commit(c, nit, KV, kvr);
        __syncthreads();
        if (un < nT) { const NaTask tn = na_decode(un + ubase, nA); kv_issue(c, proj, C_NAK + tn.h * 64, tn.b, na_rs(tn.rp), tn.ctxq ? 4 : NA_NIT, kvr); }
        f32x4 O1[4], O2[4];
#pragma unroll
        for (int db = 0; db < 4; ++db) { O1[db] = (f32x4){0.f, 0.f, 0.f, 0.f}; O2[db] = (f32x4){0.f, 0.f, 0.f, 0.f}; }
#pragma unroll
        for (int kp = 0; kp < 8; ++kp) { asm volatile("" ::: "memory");
#pragma unroll
            for (int db = 0; db < 4; ++db) O1[db] = mfma16(frag_trp(KV, KVLD, 32 * kp, 16 * db, c.lane), P1[kp], O1[db]); }
        if (!ctxq) {
#pragma unroll
            for (int kp = 0; kp < 8; ++kp) { asm volatile("" ::: "memory");
#pragma unroll
                for (int db = 0; db < 4; ++db) O2[db] = mfma16(frag_trp(KV, KVLD, wrow + 64 * kp, 16 * db, c.lane), P2[kp], O2[db]); }
        }
        {
            const float M = fmaxf(m1, m2), f1 = __builtin_amdgcn_exp2f(m1 - M), f2 = __builtin_amdgcn_exp2f(m2 - M), inv = __builtin_amdgcn_rcpf(l1 * f1 + l2 * f2);
            bf16* dst = WSP(bf16, WS_MIX) + qrow * 1024 + h * 64 + 4 * gq;
#pragma unroll
            for (int q = 0; q < 2; ++q) { const f32x4 oa = (O1[2 * q] * f1 + O2[2 * q] * f2) * inv, ob = (O1[2 * q + 1] * f1 + O2[2 * q + 1] * f2) * inv;
                u32x2 wa, wb; wa.x = pk2(oa.x, oa.y); wa.y = pk2(oa.z, oa.w); wb.x = pk2(ob.x, ob.y); wb.y = pk2(ob.z, ob.w);
                const int sel = gq & 1; *(u32x4*)(dst + 32 * q + 16 * sel - 4 * sel) = widen16(wa, wb); }
        }
        q_publish(c, nn, 0);
        __syncthreads();
        u = un; un = q_read(c, 0);
    }
}
#ifndef SUB6
#define SUB6 7
#endif
DI void phase_outputs(const Ctx& c, const Args& a, int layer, int sub, int qid) {
    const int sc_lo = layer == 0 ? 0 : 2, nsc = NSC - sc_lo, nS = NB * nsc, nM = 2 * nS, nA = NB * 8 * 64, nC = layer == 0 ? NB * 8 * 2 : 0, nH = nS + nM, nT = nH + nA + nC - NA_FILL;
    unsigned* q = WSP(unsigned, WS_CTL) + CW_Q + 64 * qid;
    int cur = blockIdx.x + ((sub & 3) ? 0 : nH), nxt;
    { const int v = q_pop_issue(c, q) + ((sub & 3) ? 0 : nH); q_publish(c, v, 0); __syncthreads(); nxt = q_read(c, 0); __syncthreads(); }
    if (!(sub & 4) && cur >= nH) return;
    while (cur < nH) {
        const int nn = q_pop_issue(c, q);
        if (cur < nS) { if (sub & 1) ssd_out_task(c, a, layer, cur / nsc, sc_lo + cur % nsc); }
        else { const int u = cur - nS, b = u / (2 * nsc), rem = u % (2 * nsc); if (sub & 2) ml_out_task(c, a, layer, b, sc_lo + (rem >> 1), rem & 1); }
        q_publish(c, nn, 0); __syncthreads(); cur = nxt; nxt = q_read(c, 0); __syncthreads();
    }
    if (sub & 4) na_tasks(c, a, layer, cur - nH, nxt - nH, nA, nT - nH, q, (sub & 3) ? nH : 0, NA_FILL);
}

DI void phase_norm2_router(const Ctx& c, const Args& a, int layer, int M, int dummy, int qid, unsigned* ctxdone) {
    constexpr int LDV = 1032;
    LAS bf16* vhi = (LAS bf16*)c.lds; LAS bf16* vlo = vhi + 32 * LDV;
    LAS float* P = (LAS float*)c.lds;
    LAS float* lg = (LAS float*)(c.lds + 132096);
    LAS int* lcnt = (LAS int*)(c.lds + 136320); LAS int* lbase = lcnt + 32; LAS int* sel = lcnt + 64; LAS int* selr = sel + 128; LAS float* selw = (LAS float*)(selr + 128);
    const float* mod = WSP(float, WS_MOD); const bf16* H = WSP(bf16, WS_H); unsigned char* U8 = WSP(unsigned char, WS_U);
    const float* ng = a.in[I_NORMG] + (layer * 2 + 1) * 1024; const float* rb = a.in[I_RB] + layer * 32;
    unsigned* cnt = WSP(unsigned, WS_CTL) + CW_CNT + layer * 32 + dummy * 128;
    int* tok_e = WSP(int, WS_ROUTE); int* tok_slot = tok_e + NTOK * 4; float* tok_w = (float*)(tok_slot + NTOK * 4);
    int* etok = (int*)(WSP(unsigned char, WS_ACT) + (size_t)MPAD * 1024);
    const int ci = c.lane & 15, gq = c.lane >> 4;
    bf16x8 whi[4][2], wlo[4][2];
    { const bf16* rwt = WSP(bf16, WS_RWT) + (size_t)layer * 2 * 32 * 1024;
#pragma unroll
      for (int ks = 0; ks < 4; ++ks)
#pragma unroll
        for (int eb = 0; eb < 2; ++eb) { const bf16* p = rwt + (16 * eb + ci) * 1024 + 128 * c.wave + 32 * ks + 8 * gq; whi[ks][eb] = *(const bf16x8*)p; wlo[ks][eb] = *(const bf16x8*)(p + 32 * 1024); } }
    unsigned* q = WSP(unsigned, WS_CTL) + CW_Q + 64 * qid;
    int tile, tnext;
    { const int v = q_pop_issue(c, q) - c.G; q_publish(c, v, 0); __syncthreads(); tile = q_read(c, 0); __syncthreads(); }
    { const int v = q_pop_issue(c, q) - c.G; q_publish(c, v, 0); __syncthreads(); tnext = q_read(c, 0); __syncthreads(); }
    while (tile < M / 32) {
        const int tnn = q_pop_issue(c, q) - c.G;
        if (ctxdone && tile >= NLAT / 32) {
            if (c.tid == 0) { unsigned sp = 0; while (__hip_atomic_load(ctxdone, __ATOMIC_RELAXED, __HIP_MEMORY_SCOPE_AGENT) < 16u) { __builtin_amdgcn_s_sleep(2); if (++sp > (1u << 22)) break; }
                __builtin_amdgcn_fence(__ATOMIC_ACQUIRE, "agent"); asm volatile("s_waitcnt vmcnt(0)" ::: "memory"); }
            __syncthreads();
        }
        {
            f32x4 v[4][4]; float ss[4];
#pragma unroll
            for (int rr = 0; rr < 4; ++rr) { const int row = tile * 32 + c.wave * 4 + rr; ss[rr] = 0.f;
#pragma unroll
                for (int j = 0; j < 4; ++j) { const u32x2 hv = *(const u32x2*)(H + (size_t)row * 1024 + 4 * (c.lane + 64 * j)); v[rr][j] = (f32x4){bflo(hv.x), bfhi(hv.x), bflo(hv.y), bfhi(hv.y)}; ss[rr] += (v[rr][j].x * v[rr][j].x + v[rr][j].y * v[rr][j].y) + (v[rr][j].z * v[rr][j].z + v[rr][j].w * v[rr][j].w); } }
            f32x4 gs[4], shv[4];
            { const int trow = tile * 32, r = trow < NLAT ? trow >> 13 : 4; const float* m = mod + (layer * 5 + r) * 6144;
#pragma unroll
              for (int j = 0; j < 4; ++j) { const int col = 4 * (c.lane + 64 * j); gs[j] = *(const f32x4*)(ng + col) * (*(const f32x4*)(m + 4 * 1024 + col) + 1.f); shv[j] = *(const f32x4*)(m + 3 * 1024 + col); } }
#pragma unroll
            for (int rr = 0; rr < 4; ++rr) {
                const int lrow = c.wave * 4 + rr, row = tile * 32 + lrow;
                const float rstd = rsqrtf(wave_sum(ss[rr]) * (1.f / 1024.f) + EPS);
#pragma unroll
                for (int j = 0; j < 4; ++j) { const int col = 4 * (c.lane + 64 * j);
                    const f32x4 o = (v[rr][j] * rstd) * gs[j] + shv[j];
                    u32x2 w; w.x = pk2(o.x, o.y); w.y = pk2(o.z, o.w); *(unsigned*)(U8 + (size_t)row * 1024 + col) = pk4_fp8(o.x, o.y, o.z, o.w);
                    *(LAS u32x2*)(vhi + lrow * LDV + col) = w;
                    u32x2 wl; wl.x = pk2(o.x - bflo(w.x), o.y - bfhi(w.x)); wl.y = pk2(o.z - bflo(w.y), o.w - bfhi(w.y));
                    *(LAS u32x2*)(vlo + lrow * LDV + col) = wl; }
            }
        }
        __syncthreads();
        f32x4 acc[2][2];
#pragma unroll
        for (int eb = 0; eb < 2; ++eb)
#pragma unroll
            for (int tb = 0; tb < 2; ++tb) acc[eb][tb] = (f32x4){0.f, 0.f, 0.f, 0.f};
#pragma unroll
        for (int ks = 0; ks < 4; ++ks) {
            bf16x8 bh[2], bl[2];
#pragma unroll
            for (int tb = 0; tb < 2; ++tb) { bh[tb] = frag_kc(vhi, LDV, 16 * tb, 128 * c.wave + 32 * ks, c.lane); bl[tb] = frag_kc(vlo, LDV, 16 * tb, 128 * c.wave + 32 * ks, c.lane); }
#pragma unroll
            for (int eb = 0; eb < 2; ++eb)
#pragma unroll
                for (int tb = 0; tb < 2; ++tb) { acc[eb][tb] = mfma16(whi[ks][eb], bh[tb], acc[eb][tb]); acc[eb][tb] = mfma16(whi[ks][eb], bl[tb], acc[eb][tb]); acc[eb][tb] = mfma16(wlo[ks][eb], bh[tb], acc[eb][tb]); }
        }
        __syncthreads();
#pragma unroll
        for (int eb = 0; eb < 2; ++eb)
#pragma unroll
            for (int tb = 0; tb < 2; ++tb) *(LAS f32x4*)(P + (c.wave * 32 + 16 * tb + ci) * 36 + 16 * eb + 4 * gq) = acc[eb][tb];
        __syncthreads();
        { const int tok = c.tid >> 4, e0 = (c.tid & 15) * 2; float s0 = rb[e0], s1 = rb[e0 + 1];
#pragma unroll
          for (int w8 = 0; w8 < 8; ++w8) { const f32x2 p = *(const LAS f32x2*)(P + (w8 * 32 + tok) * 36 + e0); s0 += p.x; s1 += p.y; }
          lg[tok * 33 + e0] = s0; lg[tok * 33 + e0 + 1] = s1;
          if (c.tid < 32) lcnt[c.tid] = 0; }
        __syncthreads();
#pragma unroll
        for (int tt = 0; tt < 4; ++tt) {
            const int tok = 4 * c.wave + tt; float x = c.lane < 32 ? lg[tok * 33 + c.lane] : -INFINITY;
            float vals[4]; int ids[4];
#pragma unroll
            for (int k = 0; k < 4; ++k) { const float mx = wave_max(x); const unsigned long long bal = __ballot(x == mx); const int idx = __ffsll((long long)bal) - 1; vals[k] = mx; ids[k] = idx; if (c.lane == idx) x = -INFINITY; }
            float wv[4], den = 0.f;
#pragma unroll
            for (int k = 0; k < 4; ++k) { wv[k] = __expf(vals[k] - vals[0]); den += wv[k]; }
            if (c.lane < 4) { const int id = c.lane == 0 ? ids[0] : (c.lane == 1 ? ids[1] : (c.lane == 2 ? ids[2] : ids[3]));
                const float wk = (c.lane == 0 ? wv[0] : (c.lane == 1 ? wv[1] : (c.lane == 2 ? wv[2] : wv[3]))) / den;
                sel[tok * 4 + c.lane] = id; selw[tok * 4 + c.lane] = wk; selr[tok * 4 + c.lane] = __hip_atomic_fetch_add(&lcnt[id], 1, __ATOMIC_RELAXED, __HIP_MEMORY_SCOPE_WORKGROUP); }
        }
        __syncthreads();
        if (c.tid < 32) { const int n = lcnt[c.tid]; lbase[c.tid] = n ? (int)__hip_atomic_fetch_add(cnt + c.tid, (unsigned)n, __ATOMIC_RELAXED, __HIP_MEMORY_SCOPE_AGENT) : 0; }
        __syncthreads();
        if (c.tid < 128) { const int id = sel[c.tid], o = tile * 128 + c.tid, slot = lbase[id] + selr[c.tid]; tok_e[o] = id; tok_slot[o] = slot; tok_w[o] = selw[c.tid];
            if (!dummy) etok[(size_t)id * ECAP + slot] = o >> 2; }
        q_publish(c, tnn, 0);
        __syncthreads();
        tile = tnext; tnext = q_read(c, 0);
    }
}
DI void phase_gather(const Ctx& c, int layer, int M) {
    LAS int* pbase = (LAS int*)c.lds;
    const unsigned* cnt = WSP(unsigned, WS_CTL) + CW_CNT + layer * 32;
    const int* tok_e = WSP(int, WS_ROUTE); const int* tok_slot = tok_e + NTOK * 4;
    if (c.tid == 0) { int s = 0; for (int e = 0; e < 32; ++e) { pbase[e] = s; s += ((int)cnt[e] + 255) & ~255; } pbase[32] = s; }
    __syncthreads();
    const unsigned char* U8 = WSP(unsigned char, WS_U); unsigned char* XP8 = WSP(unsigned char, WS_ACT);
    for (int pair = blockIdx.x * NWAVES + c.wave; pair < M * 4; pair += c.G * NWAVES) {
        const int tok = pair >> 2, prow = pbase[tok_e[pair]] + tok_slot[pair];
        const u32x4* s = (const u32x4*)(U8 + (size_t)tok * 1024); u32x4* d = (u32x4*)(XP8 + (size_t)MPAD * 1024 + (size_t)prow * 1024);
        d[c.lane] = s[c.lane];
    }
    __syncthreads();
}
DI int build_tiles(const Ctx& c, int layer, LAS int* tile_e) {
    const unsigned* cnt = WSP(unsigned, WS_CTL) + CW_CNT + layer * 32;
    int s = 0, mine = -1;
    for (int e = 0; e < 32; ++e) { const int n = ((int)cnt[e] + 255) >> 8; if (c.tid >= s && c.tid < s + n) mine = e; s += n; }
    if (s > MAXTILES) s = MAXTILES;
    if (c.tid < s && c.tid < NTHR) { tile_e[c.tid] = mine; int s3 = 0; for (int e = 0; e < mine; ++e) s3 += ((int)cnt[e] + 255) >> 8; tile_e[MAXTILES + c.tid] = (c.tid - s3) * 256; }
    if (c.tid + NTHR < s) { int s2 = 0, m2 = -1; const int t2 = c.tid + NTHR; for (int e = 0; e < 32; ++e) { const int n = ((int)cnt[e] + 255) >> 8; if (t2 >= s2 && t2 < s2 + n) m2 = e; s2 += n; } tile_e[t2] = m2; int s3 = 0; for (int e = 0; e < m2; ++e) s3 += ((int)cnt[e] + 255) >> 8; tile_e[MAXTILES + t2] = (t2 - s3) * 256; }
    __syncthreads();
    return s;
}
DI void phase_final(const Ctx& c, const Args& a) {
    const float* mod = WSP(float, WS_MOD);
    LAS int* pbase = (LAS int*)c.lds; build_pbase(c, 1, pbase);
    f32x4 cg2[4]; int rprev = -1;
    COMB_PIPE_BEGIN(NLAT, true)
        if ((row >> 13) != rprev) { rprev = row >> 13; vec4_load(c, mod + (1 * 5 + rprev) * 6144 + 5 * 1024, cg2); }
        f32x4 v[4]; comb_reduce(c, r0, yc, hc, cg2, v);
#pragma unroll
        for (int j = 0; j < 4; ++j) __builtin_nontemporal_store(v[j], (f32x4*)(a.out + (size_t)row * 1024 + 4 * (c.lane + 64 * j)));
    COMB_PIPE_END()
    __syncthreads();
}

__global__ void __launch_bounds__(NTHR, 2) fwd(Args a) {
    extern __shared__ __attribute__((aligned(16))) unsigned char lds_raw[];
    Ctx c; c.lds = (LAS unsigned char*)lds_raw; c.tid = threadIdx.x; c.lane = c.tid & 63; c.wave = __builtin_amdgcn_readfirstlane(c.tid >> 6); c.G = gridDim.x; c.ws = a.ws;
    volatile LAS unsigned* MISC = (volatile LAS unsigned*)(c.lds + MISC_OFF);
    if (c.tid < 64) MISC[c.tid] = 0u;
    __syncthreads();
    XcdBarrier bar = xcd_barrier_post(WSP(unsigned, WS_CTL) + CW_BAR + a.li * XCD_BAR_WORDS, MISC + 8);
    const int lo = a.ph_lo, hi = a.ph_hi;
    const int vcu = (c.G % 8 == 0) ? ((int)blockIdx.x % 8) * (c.G / 8) + (int)blockIdx.x / 8 : (int)blockIdx.x;
#ifndef PT_MASK
#define PT_MASK 0xFFFF
#endif
#define PT(t) ((PT_MASK >> (t)) & 1)
#ifndef DUP_MASK
#define DUP_MASK 0
#endif
#define DUP(t) ((DUP_MASK >> (t)) & 1)
#ifndef DUPN
#define DUPN 1
#endif
#ifndef KPROBE
#define KPROBE 512
#endif
#ifndef DUP6_SUB
#define DUP6_SUB 7
#endif
#define IN(k) (fresh_ctx(c), (lo <= (k) && (k) < hi))
#define SEAM(k) do { if (IN(k) && IN((k) + 1)) xcd_barrier(bar); } while (0)
    if (PT(0) && IN(0)) { phase_ada(c, a); if (DUP(0)) { xcd_barrier(bar); phase_ada(c, a); } }
    SEAM(0);
    if (PT(1) && IN(1)) { phase_convert(c, a); if (DUP(1)) { xcd_barrier(bar); phase_convert(c, a); } }
    if (PT(2) && IN(1)) phase_norm1(c, a, 0);
    SEAM(1);
    for (int layer = 0; layer < DEPTH; ++layer) {
        const int pb = 2 + 10 * layer, M = layer == 0 ? NTOK : NLAT;
        if (layer > 0) { if (PT(2) && IN(pb + 0)) phase_norm1(c, a, layer); SEAM(pb + 0); }
        if (PT(3) && IN(pb + 1)) for (int rep = 0; rep < 1 + DUPN * DUP(3); ++rep) {
            if (rep) xcd_barrier(bar);
            pg8::Gemm g{WSP(bf16, WS_U), WSP(bf16, WS_WIN) + (size_t)layer * NPAD * 1024, NTOK, NPAD, 1024}; pg8::StaticOrder S; S.init(NTOK, NPAD, c.G, (int)blockIdx.x);
            EpiProj E{WSP(bf16, WS_PROJ), WSP(float, WS_GATES), a.in[I_QKG] + layer * 128};
            pg8::gemm_phase<EpiProj, pg8::StaticOrder, true, true>(c.lds, g, S, E);
        }
        SEAM(pb + 1);
        if (PT(4) && IN(pb + 2)) phase_local(c, a, layer, layer * 4 + 2);
        SEAM(pb + 2);
        if (PT(5) && IN(pb + 3)) phase_scan(c);
        if (DUP(4)) { xcd_barrier(bar); phase_local(c, a, layer, layer * 4 + 3); xcd_barrier(bar); phase_scan(c); }

        SEAM(pb + 3);
        if (PT(6) && IN(pb + 4)) { phase_outputs(c, a, layer, 7, layer * 4 + 0); if (DUP(6)) { xcd_barrier(bar); phase_outputs(c, a, layer, DUP6_SUB, layer * 4 + 1); } }
        SEAM(pb + 4);
        if (PT(7) && IN(pb + 5)) {
            pg8::Gemm g{WSP(bf16, WS_MIX), WSP(bf16, WS_WOUT) + (size_t)layer * 1024 * 1024, NLAT, 1024, 1024}; pg8::StaticOrder S; S.init(NLAT, 1024, c.G, (int)blockIdx.x);
            EpiRes E{WSP(bf16, WS_H), WSP(float, WS_MOD) + layer * 5 * 6144 + 2 * 1024, a.in[I_X], a.in[I_CTX], layer};
            pg8::gemm_phase<EpiRes, pg8::StaticOrder, true, true>(c.lds, g, S, E);
        }
        SEAM(pb + 5);
        if (PT(8) && IN(pb + 6)) {
            unsigned* ctxdone = WSP(unsigned, WS_CTL) + 200704;
            if (layer == 0) {
                for (int cu = blockIdx.x; cu < 16; cu += c.G) {
                    pg8::Gemm g{WSP(bf16, WS_MIX), WSP(bf16, WS_WOUT), NTOK, 1024, 1024}; OneUnit S{128 + (cu >> 2), cu & 3};
                    EpiRes E{WSP(bf16, WS_H), WSP(float, WS_MOD) + 2 * 1024, a.in[I_X], a.in[I_CTX], 0};
                    pg8::gemm_phase<EpiRes, OneUnit, true, true>(c.lds, g, S, E);
                    asm volatile("s_waitcnt vmcnt(0)" ::: "memory");
                    __syncthreads();
                    if (c.tid == 0) { __builtin_amdgcn_fence(__ATOMIC_RELEASE, "agent"); asm volatile("s_waitcnt vmcnt(0)" ::: "memory");
                        __hip_atomic_fetch_add(ctxdone, 1u, __ATOMIC_RELAXED, __HIP_MEMORY_SCOPE_AGENT); }
                    __syncthreads();
                }
            }
            phase_norm2_router(c, a, layer, M, 0, 8 + layer, layer == 0 ? ctxdone : nullptr);
        }
        SEAM(pb + 6);
        if (PT(10) && IN(pb + 8)) for (int rep = 0; rep < 1 + DUPN * DUP(10); ++rep) {
            if (rep) xcd_barrier(bar);
            LAS int* tile_e = (LAS int*)(c.lds + LDS_TILE_OFF); const int nt = __builtin_amdgcn_readfirstlane(build_tiles(c, layer, tile_e));
            pg8::Gemm g{(const pg8::bf16_t*)WSP(unsigned char, WS_U), (const pg8::bf16_t*)(WSP(unsigned char, WS_W1) + (size_t)layer * 32 * 2048 * 1024), MPAD, 2048, 512};
            MoeOrder S{tile_e, nt, 3, c.G, vcu, (const int*)(WSP(unsigned char, WS_ACT) + (size_t)MPAD * 1024), WSP(unsigned, WS_CTL) + CW_CNT + layer * 32};
            EpiSwiglu E{WSP(unsigned char, WS_ACT), a.in[I_B1] + (size_t)layer * 32 * 2048};
            pg8::gemm_phase<EpiSwiglu, MoeOrder, true, true, true, true>(c.lds, g, S, E);
        }
        SEAM(pb + 8);
        if (PT(11) && IN(pb + 9)) for (int rep = 0; rep < 1 + DUPN * DUP(11); ++rep) {
            if (rep) xcd_barrier(bar);
            LAS int* tile_e = (LAS int*)(c.lds + LDS_TILE_OFF); const int nt = __builtin_amdgcn_readfirstlane(build_tiles(c, layer, tile_e));
            pg8::Gemm g{(const pg8::bf16_t*)WSP(unsigned char, WS_ACT), (const pg8::bf16_t*)(WSP(unsigned char, WS_W2) + (size_t)layer * 32 * 1024 * 1024), MPAD, 1024, (DUP(11) && rep == 0) ? KPROBE : 512};
            MoeOrder S{tile_e, nt, 2, c.G, vcu, nullptr, nullptr};
            EpiMoeOut E{WSP(unsigned char, WS_XP), a.in[I_B2] + (size_t)layer * 32 * 1024};
            pg8::gemm_phase<EpiMoeOut, MoeOrder, true, true, true>(c.lds, g, S, E);
        }
        SEAM(pb + 9);
    }
    if (DUP(13)) { for (int i = 0; i < 10; ++i) xcd_barrier(bar); }
    if (PT(12) && IN(22)) { phase_final(c, a); if (DUP(12)) { xcd_barrier(bar); phase_final(c, a); } }
#undef IN
#undef SEAM
}

#ifndef MK_CUTS
#define MK_CUTS 0
#endif
extern "C" void kernel_launch(void* const* d_in, const int* in_sizes, int n_in, void* d_out, int out_size, void* d_ws, size_t ws_size, hipStream_t stream) {
    static int grid = 0;
    if (grid == 0) {
        if (n_in != 25 || out_size != NLAT * D || ws_size < WS_END) { fprintf(stderr, "kernel_launch: unexpected shapes (n_in %d out %d ws %zu)\n", n_in, out_size, ws_size); grid = -1; return; }
        int dev = 0, cus = 0, per_cu = 0;
        if (hipGetDevice(&dev) != hipSuccess || hipDeviceGetAttribute(&cus, hipDeviceAttributeMultiprocessorCount, dev) != hipSuccess) { grid = -1; return; }
        if (hipFuncSetAttribute((const void*)fwd, hipFuncAttributeMaxDynamicSharedMemorySize, LDS_BYTES) != hipSuccess) { fprintf(stderr, "kernel_launch: hipFuncSetAttribute failed\n"); grid = -1; return; }
        if (hipOccupancyMaxActiveBlocksPerMultiprocessor(&per_cu, (const void*)fwd, NTHR, LDS_BYTES) != hipSuccess || per_cu < 1) { fprintf(stderr, "kernel_launch: occupancy query says %d\n", per_cu); }
        (void)hipGetLastError();
        grid = cus;
    }
    if (grid < 0) return;
    if (hipMemsetAsync((char*)d_ws + WS_CTL, 0, CTL_ZERO_BYTES, stream) != hipSuccess) return;
    Args a{};
    for (int i = 0; i < 25; ++i) a.in[i] = (const float*)d_in[i];
    a.out = (float*)d_out; a.ws = (unsigned char*)d_ws; a.pad = 0;
#if MK_CUTS == 0
    a.ph_lo = 0; a.ph_hi = NPHASES; a.li = 0;
    hipLaunchKernelGGL(fwd, dim3(grid), dim3(NTHR), LDS_BYTES, stream, a);
#else
    for (int p = 0; p < NPHASES; ++p) { a.ph_lo = p; a.ph_hi = p + 1; a.li = p; hipLaunchKernelGGL(fwd, dim3(grid), dim3(NTHR), LDS_BYTES, stream, a); }
#endif
}
```
